# Optimizing an MI355X kernel written in HIP

```python
import math
import jax, jax.numpy as jnp
from jax import lax
import numpy as np

D_MODEL = 1024
BATCH = 4
SEQ = 4096
DEPTH = 4
DEC_BATCH = 8
DEC_SEQ = 64
PAST_LEN = 2048

CHUNK = 64
N_PREV_CHUNKS = 8
HEAD_DIM = 64
A_HEADS = 4
REL_CLIP = 128
B_HEADS = 4
B_V_DIM = 2 * HEAD_DIM
C_HEADS = 4
C_Q_LORA = 384
C_KV_LORA = 256
C_NOPE = 64
C_ROPE = 32
C_V = 64
ROPE_THETA = 10000.0
N_MEM = 256
M_HEADS = 4
M_HEAD_DIM = 128
D_FF = 2816
EPS = 1e-6
Q_BLOCK = 128
NEG_INF = -1e30

A_WIDTH = A_HEADS * HEAD_DIM
B_QK_COLS = 4 * B_HEADS * HEAD_DIM
B_WIDTH = B_HEADS * B_V_DIM
C_WIDTH = C_HEADS * C_V
MIX_WIDTH = A_WIDTH + B_WIDTH + C_WIDTH
A_COLS = 3 * A_WIDTH
B_COLS = B_QK_COLS + B_WIDTH
C_COLS = C_Q_LORA + C_KV_LORA + C_ROPE
IN_COLS = A_COLS + B_COLS + C_COLS
M_WIDTH = M_HEADS * M_HEAD_DIM

kernel_name = 'hybrid_streaming_encoder_step'


def rms_norm(x, g):
    xf = x.astype(jnp.float32)
    y = xf * lax.rsqrt(jnp.mean(xf * xf, axis=-1, keepdims=True) + EPS)
    return (y * g.astype(jnp.float32)).astype(x.dtype)


def half_ffn(x, g, w_gate, w_up, w_down):
    h = rms_norm(x, g)
    return 0.5 * ((jax.nn.silu(h @ w_gate) * (h @ w_up)) @ w_down)


def rope(x, pos):
    half = C_ROPE // 2
    inv = ROPE_THETA ** (-jnp.arange(half, dtype=jnp.float32) / half)
    ang = pos.astype(jnp.float32)[:, None] * inv[None, :]
    shape = (ang.shape[0],) + (1,) * (x.ndim - 3) + (half,)
    cos = jnp.cos(ang).reshape(shape)
    sin = jnp.sin(ang).reshape(shape)
    xf = x.astype(jnp.float32)
    x1, x2 = xf[..., :half], xf[..., half:]
    return jnp.concatenate([x1 * cos - x2 * sin, x1 * sin + x2 * cos], axis=-1).astype(x.dtype)


def alibi_slopes(n):
    return jnp.exp2(-8.0 * (jnp.arange(n, dtype=jnp.float32) + 1.0) / n)


def chunk_causal(q_pos, k_pos):
    return (k_pos[None, :] // CHUNK) <= (q_pos[:, None] // CHUNK)


def map_query_blocks(fn, q, q_pos):
    b, s = q.shape[:2]
    nb = s // Q_BLOCK
    qb = jnp.moveaxis(q.reshape((b, nb, Q_BLOCK) + q.shape[2:]), 1, 0)
    pb = q_pos.reshape(nb, Q_BLOCK)
    out = lax.map(lambda a: fn(a[0], a[1]), (qb, pb))
    out = jnp.moveaxis(out, 0, 1)
    return out.reshape((b, s) + out.shape[3:])


def mix_projections(h, pos, p):
    b, t = h.shape[:2]
    u = h @ p['w_in']
    a = u[..., :A_COLS].reshape(b, t, 3, A_HEADS, HEAD_DIM)
    qa = rms_norm(a[:, :, 0], p['a_q_norm'])
    ka = rms_norm(a[:, :, 1], p['a_k_norm'])
    va = a[:, :, 2]
    bqk = u[..., A_COLS:A_COLS + B_QK_COLS].reshape(b, t, 2, B_HEADS, 2, HEAD_DIM)
    qb = rms_norm(bqk[:, :, 0], p['b_q_norm'])
    kb = rms_norm(bqk[:, :, 1], p['b_k_norm'])
    vb = u[..., A_COLS + B_QK_COLS:A_COLS + B_COLS].reshape(b, t, B_HEADS, B_V_DIM)
    c = u[..., A_COLS + B_COLS:]
    c_q = rms_norm(c[..., :C_Q_LORA], p['c_q_lat_norm'])
    c_kv = rms_norm(c[..., C_Q_LORA:C_Q_LORA + C_KV_LORA], p['c_kv_lat_norm'])
    k_pe = rope(c[..., C_Q_LORA + C_KV_LORA:], pos)
    qc = (c_q @ p['c_w_uq']).reshape(b, t, C_HEADS, C_NOPE + C_ROPE)
    qc = jnp.concatenate([qc[..., :C_NOPE], rope(qc[..., C_NOPE:], pos)], axis=-1)
    qc = rms_norm(qc, p['c_q_norm'])
    return qa, ka, va, qb, kb, vb, qc, c_kv, k_pe


def band_attention(q, k, v, q_pos, k_pos, rel_table):
    s = jnp.einsum('bqhd,bkhd->bhqk', q, k).astype(jnp.float32) * (HEAD_DIM ** -0.5)
    rel = jnp.clip(q_pos[:, None] - k_pos[None, :], -REL_CLIP, REL_CLIP) + REL_CLIP
    s = s + rel_table.astype(jnp.float32)[:, rel]
    qc = q_pos[:, None] // CHUNK
    kc = k_pos[None, :] // CHUNK
    vis = (k_pos[None, :] >= 0) & (kc <= qc) & (kc >= qc - N_PREV_CHUNKS)
    prob = jax.nn.softmax(jnp.where(vis, s, NEG_INF), axis=-1)
    return jnp.einsum('bhqk,bkhd->bqhd', prob.astype(v.dtype), v)


def band_attention_prompt(q, k, v, rel_table):
    b, s = q.shape[:2]
    nc = s // CHUNK
    reach = N_PREV_CHUNKS * CHUNK
    band = reach + CHUNK
    pad = ((0, 0), (reach, 0), (0, 0), (0, 0))
    kp = jnp.pad(k, pad)
    vp = jnp.pad(v, pad)
    idx = jnp.arange(nc)[:, None] * CHUNK + jnp.arange(band)[None, :]
    kb = kp[:, idx]
    vb = vp[:, idx]
    qb = q.reshape(b, nc, CHUNK, A_HEADS, HEAD_DIM)
    q_pos = jnp.arange(s).reshape(nc, CHUNK)
    k_pos = idx - reach
    out = jax.vmap(band_attention, in_axes=(1, 1, 1, 0, 0, None), out_axes=1)(qb, kb, vb, q_pos, k_pos, rel_table)
    return out.reshape(b, s, A_HEADS, HEAD_DIM)


def diff_lambda(b_lambda, lam_init):
    lf = b_lambda.astype(jnp.float32)
    return jnp.exp(jnp.sum(lf[0] * lf[1])) - jnp.exp(jnp.sum(lf[2] * lf[3])) + lam_init


def diff_attention(q, k, v, q_pos, k_pos, lam):
    s = jnp.einsum('bqhjd,bkhjd->bjhqk', q, k).astype(jnp.float32) * (HEAD_DIM ** -0.5)
    dist = jnp.abs(q_pos[:, None] - k_pos[None, :]).astype(jnp.float32)
    s = s - alibi_slopes(B_HEADS)[:, None, None] * dist
    s = jnp.where(chunk_causal(q_pos, k_pos), s, NEG_INF)
    prob = jax.nn.softmax(s, axis=-1)
    a = prob[:, 0] - lam * prob[:, 1]
    return jnp.einsum('bhqk,bkhe->bqhe', a.astype(v.dtype), v)


def mla_keys(c_kv, k_pe, w_ukv, k_norm):
    b, t = c_kv.shape[:2]
    kv = (c_kv @ w_ukv).reshape(b, t, C_HEADS, C_NOPE + C_V)
    k = jnp.concatenate([kv[..., :C_NOPE], jnp.broadcast_to(k_pe[:, :, None, :], (b, t, C_HEADS, C_ROPE))], axis=-1)
    return rms_norm(k, k_norm), kv[..., C_NOPE:]


def latent_attention(q, k, v, q_pos, k_pos):
    s = jnp.einsum('bqhd,bkhd->bhqk', q, k).astype(jnp.float32) * ((C_NOPE + C_ROPE) ** -0.5)
    prob = jax.nn.softmax(jnp.where(chunk_causal(q_pos, k_pos), s, NEG_INF), axis=-1)
    return jnp.einsum('bhqk,bkhd->bqhd', prob.astype(v.dtype), v)


def merge_heads(oa, ob, oc, b_sub_norm, w_out, lam_init):
    b, t = oa.shape[:2]
    ob = rms_norm(ob, b_sub_norm) * (1.0 - lam_init)
    o = jnp.concatenate([oa.reshape(b, t, A_WIDTH), ob.reshape(b, t, B_WIDTH), oc.reshape(b, t, C_WIDTH)], axis=-1)
    return o @ w_out


def memory_kv(mem, p):
    b, m = mem.shape[:2]
    mn = rms_norm(mem, p['mem_norm_m'])
    k = rms_norm((mn @ p['mem_w_k']).reshape(b, m, M_HEADS, M_HEAD_DIM), p['mem_k_norm'])
    v = (mn @ p['mem_w_v']).reshape(b, m, M_HEADS, M_HEAD_DIM)
    return k, v


def memory_attention(x, k, v, p):
    b, t = x.shape[:2]
    q = (rms_norm(x, p['mem_norm_x']) @ p['mem_w_q']).reshape(b, t, M_HEADS, M_HEAD_DIM)
    q = rms_norm(q, p['mem_q_norm'])
    s = jnp.einsum('bqhd,bmhd->bhqm', q, k).astype(jnp.float32) * (M_HEAD_DIM ** -0.5)
    prob = jax.nn.softmax(s, axis=-1)
    o = jnp.einsum('bhqm,bmhd->bqhd', prob.astype(v.dtype), v)
    return o.reshape(b, t, M_WIDTH) @ p['mem_w_o']


def prompt_layer(x, mem, p, lam_init):
    s = x.shape[1]
    pos = jnp.arange(s)
    x = x + half_ffn(x, p['ffn1_norm'], p['ffn1_w_gate'], p['ffn1_w_up'], p['ffn1_w_down'])
    h = rms_norm(x, p['mix_norm'])
    qa, ka, va, qb, kb, vb, qc, c_kv, k_pe = mix_projections(h, pos, p)
    oa = band_attention_prompt(qa, ka, va, p['a_rel_bias'])
    lam = diff_lambda(p['b_lambda'], lam_init)
    ob = map_query_blocks(lambda qq, qp: diff_attention(qq, kb, vb, qp, pos, lam), qb, pos)
    kc, vc = mla_keys(c_kv, k_pe, p['c_w_ukv'], p['c_k_norm'])
    oc = map_query_blocks(lambda qq, qp: latent_attention(qq, kc, vc, qp, pos), qc, pos)
    x = x + merge_heads(oa, ob, oc, p['b_sub_norm'], p['w_out'], lam_init)
    mk, mv = memory_kv(mem, p)
    x = x + memory_attention(x, mk, mv, p)
    x = x + half_ffn(x, p['ffn2_norm'], p['ffn2_w_gate'], p['ffn2_w_up'], p['ffn2_w_down'])
    reach = min(N_PREV_CHUNKS * CHUNK, s)
    return x, (ka[:, s - reach:], va[:, s - reach:], kb, vb, c_kv, k_pe, mk, mv)


def sample_layer(x, p, lam_init, ca_k, ca_v, cb_k, cb_v, cc_kv, cc_kpe, cm_k, cm_v):
    n = x.shape[1]
    past = cb_k.shape[1]
    a_len = ca_k.shape[1]
    pos = past + jnp.arange(n)
    x = x + half_ffn(x, p['ffn1_norm'], p['ffn1_w_gate'], p['ffn1_w_up'], p['ffn1_w_down'])
    h = rms_norm(x, p['mix_norm'])
    qa, ka, va, qb, kb, vb, qc, c_kv, k_pe = mix_projections(h, pos, p)
    a_pos = jnp.concatenate([past - a_len + jnp.arange(a_len), pos])
    oa = band_attention(qa, jnp.concatenate([ca_k, ka], axis=1), jnp.concatenate([ca_v, va], axis=1), pos, a_pos, p['a_rel_bias'])
    k_pos = jnp.arange(past + n)
    lam = diff_lambda(p['b_lambda'], lam_init)
    ob = diff_attention(qb, jnp.concatenate([cb_k, kb], axis=1), jnp.concatenate([cb_v, vb], axis=1), pos, k_pos, lam)
    kc, vc = mla_keys(jnp.concatenate([cc_kv, c_kv], axis=1), jnp.concatenate([cc_kpe, k_pe], axis=1), p['c_w_ukv'], p['c_k_norm'])
    oc = latent_attention(qc, kc, vc, pos, k_pos)
    x = x + merge_heads(oa, ob, oc, p['b_sub_norm'], p['w_out'], lam_init)
    x = x + memory_attention(x, cm_k, cm_v, p)
    x = x + half_ffn(x, p['ffn2_norm'], p['ffn2_w_gate'], p['ffn2_w_up'], p['ffn2_w_down'])
    return x, (ka, va, kb, vb, c_kv, k_pe)


def setup_inputs(seed: int = 0) -> dict:
    key = jax.random.key(seed)
    keys = jax.random.split(key, 64)
    counter = [0]

    def nrm(shape, scale=1.0):
        k = keys[counter[0]]
        counter[0] += 1
        return scale * jax.random.normal(k, shape, jnp.float32)

    def gain(n):
        return 1.0 + nrm((DEPTH, n), 0.02)

    def mat(fan_in, fan_out):
        return nrm((DEPTH, fan_in, fan_out), fan_in ** -0.5)

    a_len = min(N_PREV_CHUNKS * CHUNK, PAST_LEN)
    return {
        'x_prompt': nrm((BATCH, SEQ, D_MODEL)),
        'x_sample': nrm((DEC_BATCH, DEC_SEQ, D_MODEL)),
        'mem_prompt': nrm((BATCH, N_MEM, D_MODEL)),
        'cache_a_k': nrm((DEPTH, DEC_BATCH, a_len, A_HEADS, HEAD_DIM)),
        'cache_a_v': nrm((DEPTH, DEC_BATCH, a_len, A_HEADS, HEAD_DIM)),
        'cache_b_k': nrm((DEPTH, DEC_BATCH, PAST_LEN, B_HEADS, 2, HEAD_DIM)),
        'cache_b_v': nrm((DEPTH, DEC_BATCH, PAST_LEN, B_HEADS, B_V_DIM)),
        'cache_c_kv': nrm((DEPTH, DEC_BATCH, PAST_LEN, C_KV_LORA)),
        'cache_c_kpe': nrm((DEPTH, DEC_BATCH, PAST_LEN, C_ROPE)),
        'cache_mem_k': nrm((DEPTH, DEC_BATCH, N_MEM, M_HEADS, M_HEAD_DIM)),
        'cache_mem_v': nrm((DEPTH, DEC_BATCH, N_MEM, M_HEADS, M_HEAD_DIM)),
        'ffn1_norm': gain(D_MODEL),
        'ffn1_w_gate': mat(D_MODEL, D_FF),
        'ffn1_w_up': mat(D_MODEL, D_FF),
        'ffn1_w_down': mat(D_FF, D_MODEL),
        'mix_norm': gain(D_MODEL),
        'w_in': mat(D_MODEL, IN_COLS),
        'a_q_norm': gain(HEAD_DIM),
        'a_k_norm': gain(HEAD_DIM),
        'a_rel_bias': nrm((DEPTH, A_HEADS, 2 * REL_CLIP + 1), 0.1),
        'b_q_norm': gain(HEAD_DIM),
        'b_k_norm': gain(HEAD_DIM),
        'b_lambda': nrm((DEPTH, 4, HEAD_DIM), 0.1),
        'b_sub_norm': gain(B_V_DIM),
        'c_q_lat_norm': gain(C_Q_LORA),
        'c_kv_lat_norm': gain(C_KV_LORA),
        'c_w_uq': mat(C_Q_LORA, C_HEADS * (C_NOPE + C_ROPE)),
        'c_w_ukv': mat(C_KV_LORA, C_HEADS * (C_NOPE + C_V)),
        'c_q_norm': gain(C_NOPE + C_ROPE),
        'c_k_norm': gain(C_NOPE + C_ROPE),
        'w_out': mat(MIX_WIDTH, D_MODEL),
        'mem_norm_x': gain(D_MODEL),
        'mem_w_q': mat(D_MODEL, M_WIDTH),
        'mem_q_norm': gain(M_HEAD_DIM),
        'mem_norm_m': gain(D_MODEL),
        'mem_w_k': mat(D_MODEL, M_WIDTH),
        'mem_w_v': mat(D_MODEL, M_WIDTH),
        'mem_k_norm': gain(M_HEAD_DIM),
        'mem_w_o': mat(M_WIDTH, D_MODEL),
        'ffn2_norm': gain(D_MODEL),
        'ffn2_w_gate': mat(D_MODEL, D_FF),
        'ffn2_w_up': mat(D_MODEL, D_FF),
        'ffn2_w_down': mat(D_FF, D_MODEL),
    }


def reference(x_prompt, x_sample, mem_prompt, cache_a_k, cache_a_v, cache_b_k, cache_b_v,
              cache_c_kv, cache_c_kpe, cache_mem_k, cache_mem_v,
              ffn1_norm, ffn1_w_gate, ffn1_w_up, ffn1_w_down, mix_norm, w_in,
              a_q_norm, a_k_norm, a_rel_bias, b_q_norm, b_k_norm, b_lambda, b_sub_norm,
              c_q_lat_norm, c_kv_lat_norm, c_w_uq, c_w_ukv, c_q_norm, c_k_norm, w_out,
              mem_norm_x, mem_w_q, mem_q_norm, mem_norm_m, mem_w_k, mem_w_v, mem_k_norm, mem_w_o,
              ffn2_norm, ffn2_w_gate, ffn2_w_up, ffn2_w_down):
    xp, xs = x_prompt, x_sample
    prompt_states = [[] for _ in range(8)]
    sample_states = [[] for _ in range(6)]
    for l in range(DEPTH):
        p = {
            'ffn1_norm': ffn1_norm[l], 'ffn1_w_gate': ffn1_w_gate[l], 'ffn1_w_up': ffn1_w_up[l],
            'ffn1_w_down': ffn1_w_down[l], 'mix_norm': mix_norm[l], 'w_in': w_in[l],
            'a_q_norm': a_q_norm[l], 'a_k_norm': a_k_norm[l], 'a_rel_bias': a_rel_bias[l],
            'b_q_norm': b_q_norm[l], 'b_k_norm': b_k_norm[l], 'b_lambda': b_lambda[l],
            'b_sub_norm': b_sub_norm[l], 'c_q_lat_norm': c_q_lat_norm[l],
            'c_kv_lat_norm': c_kv_lat_norm[l], 'c_w_uq': c_w_uq[l], 'c_w_ukv': c_w_ukv[l],
            'c_q_norm': c_q_norm[l], 'c_k_norm': c_k_norm[l], 'w_out': w_out[l],
            'mem_norm_x': mem_norm_x[l], 'mem_w_q': mem_w_q[l], 'mem_q_norm': mem_q_norm[l],
            'mem_norm_m': mem_norm_m[l], 'mem_w_k': mem_w_k[l], 'mem_w_v': mem_w_v[l],
            'mem_k_norm': mem_k_norm[l], 'mem_w_o': mem_w_o[l],
            'ffn2_norm': ffn2_norm[l], 'ffn2_w_gate': ffn2_w_gate[l], 'ffn2_w_up': ffn2_w_up[l],
            'ffn2_w_down': ffn2_w_down[l],
        }
        lam_init = 0.8 - 0.6 * math.exp(-0.3 * l)
        xp, sp = prompt_layer(xp, mem_prompt, p, lam_init)
        xs, ss = sample_layer(xs, p, lam_init, cache_a_k[l], cache_a_v[l], cache_b_k[l], cache_b_v[l],
                              cache_c_kv[l], cache_c_kpe[l], cache_mem_k[l], cache_mem_v[l])
        for lst, arr in zip(prompt_states, sp):
            lst.append(arr)
        for lst, arr in zip(sample_states, ss):
            lst.append(arr)
    pak, pav, pbk, pbv, pckv, pckpe, pmk, pmv = [jnp.stack(s) for s in prompt_states]
    sak, sav, sbk, sbv, sckv, sckpe = [jnp.stack(s) for s in sample_states]
    return (xp, xs, pak, pav, pbk, pbv, pckv, pckpe, pmk, pmv, sak, sav, sbk, sbv, sckv, sckpe)
```

```cpp
#include <hip/hip_runtime.h>
#include <hip/hip_cooperative_groups.h>
#include <cstdint>
#include <cstring>
#include <cstdio>
#include <cmath>
namespace cg = cooperative_groups;
#ifndef REP_UP
#define REP_UP 0
#endif
#ifndef REP_SYNC
#define REP_SYNC 0
#endif
#ifndef REP_ATT
#define REP_ATT 0
#endif

typedef unsigned short bf16_t;
typedef short bf16x8 __attribute__((ext_vector_type(8)));
typedef short s16x4 __attribute__((ext_vector_type(4)));
typedef float f32x16 __attribute__((ext_vector_type(16)));
typedef float f32x4 __attribute__((ext_vector_type(4)));
typedef unsigned u32x4 __attribute__((ext_vector_type(4)));
typedef unsigned u32x2 __attribute__((ext_vector_type(2)));

#define DI __device__ __forceinline__
#define MFMA32(a, b, c) __builtin_amdgcn_mfma_f32_32x32x16_bf16((a), (b), (c), 0, 0, 0)

constexpr int R = 16896, RP = 16384, DM = 1024, DFF = 2816, NL = 4;
constexpr int LDS_BYTES = 128 * 272 * 4;
constexpr int NTHR = 512;
constexpr int NAJ = 288;
constexpr float LOG2E = 1.4426950408889634f;
constexpr float EPS = 1e-6f;
constexpr int NPH = 2 + 10 * NL;
#ifndef MK_MINW
#define MK_MINW 2
#endif

DI unsigned pk2(float lo, float hi) { unsigned r; asm("v_cvt_pk_bf16_f32 %0, %1, %2" : "=v"(r) : "v"(lo), "v"(hi)); return r; }
DI float b2f(bf16_t b) { return __uint_as_float((unsigned)b << 16); }
DI int crow(int r, int hi) { return (r & 3) + 8 * (r >> 2) + 4 * hi; }
DI int ltid() { int t = threadIdx.x; asm volatile("" : "+v"(t)); return t; }


#define XB_TMO      128
#define XB_XCNT(j)  (256  + 64 * (j))
#define XB_XSUB(j)  (1280 + 64 * (j))
#define XB_XGEN(j)  (2304 + 64 * (j))
#define XB_TOP      3328
#define XB_TOPGEN   3392
#define XCD_BAR_WORDS 3456
#define XB_SPIN_CAP (1u << 18)
#define LAS __attribute__((address_space(3)))
DI unsigned xb_ld(unsigned* p)              { return __hip_atomic_load(p, __ATOMIC_RELAXED, __HIP_MEMORY_SCOPE_AGENT); }
DI unsigned xb_add(unsigned* p, unsigned v) { return __hip_atomic_fetch_add(p, v, __ATOMIC_RELAXED, __HIP_MEMORY_SCOPE_AGENT); }
DI unsigned xb_xcc_id() { return (unsigned)__builtin_amdgcn_s_getreg((3 << 11) | 20) & 0xFu; }
#define XB_SPIN(cond, bar) do { unsigned _sp = 0; while (cond) { __builtin_amdgcn_s_sleep(1); \
    if ((++_sp & 255u) == 0u) { if (xb_ld(&(bar)[XB_TMO])) break; if (_sp > XB_SPIN_CAP) { atomicAdd(&(bar)[XB_TMO], 1u); break; } } } } while (0)
struct XcdBarrier { unsigned* bar; unsigned x; volatile LAS unsigned* st; };
DI XcdBarrier xcd_barrier_post(unsigned* bar, volatile LAS unsigned* st) {
  XcdBarrier b; b.bar = bar; b.x = xb_xcc_id(); b.st = st;
  if (threadIdx.x == 0) (void)xb_add(&bar[XB_XCNT(b.x)], 1u);
  return b; }
DI void xcd_barrier_complete(unsigned* bar, unsigned x, unsigned& nloc, unsigned& nx) {
  const unsigned G = gridDim.x * gridDim.y * gridDim.z;
  unsigned sum, cnt, mine, sp = 0u;
  for (;;) {
    sum = 0u; cnt = 0u; mine = 0u;
#pragma unroll
    for (unsigned j = 0; j < 16; ++j) { const unsigned c = xb_ld(&bar[XB_XCNT(j)]); sum += c; cnt += (c > 0u) ? 1u : 0u; mine = (j == x) ? c : mine; }
    if (sum == G) break;
    __builtin_amdgcn_s_sleep(1);
    if ((++sp & 255u) == 0u) { if (xb_ld(&bar[XB_TMO])) break; if (sp > XB_SPIN_CAP) { atomicAdd(&bar[XB_TMO], 1u); break; } }
  }
  nloc = mine > 0u ? mine : 1u; nx = cnt > 0u ? cnt : 1u; }
DI void xcd_barrier(const XcdBarrier& b) {
  asm volatile("s_waitcnt vmcnt(0)" ::: "memory");
  __syncthreads();
  if (threadIdx.x == 0) {
    unsigned* bar = b.bar;
    __builtin_amdgcn_s_waitcnt(0);
    unsigned nloc = b.st[0], nx = b.st[1];
    if (nloc == 0u) { xcd_barrier_complete(bar, b.x, nloc, nx); b.st[0] = nloc; b.st[1] = nx; }
    const unsigned old = xb_add(&bar[XB_XSUB(b.x)], 1u);
    const unsigned gen = old / nloc;
    if (old + 1u == (gen + 1u) * nloc) {
      __builtin_amdgcn_fence(__ATOMIC_RELEASE, "agent");
      asm volatile("s_waitcnt vmcnt(0)" ::: "memory");
      const unsigned og = xb_add(&bar[XB_TOP], 1u);
      const unsigned tg = og / nx;
      if (og + 1u == (tg + 1u) * nx) xb_add(&bar[XB_TOPGEN], 1u);
      else XB_SPIN(xb_ld(&bar[XB_TOPGEN]) == tg, bar);
      __builtin_amdgcn_fence(__ATOMIC_ACQUIRE, "agent");
      xb_add(&bar[XB_XGEN(b.x)], 1u);
      asm volatile("s_waitcnt vmcnt(0)" ::: "memory");
    } else {
      XB_SPIN(xb_ld(&bar[XB_XGEN(b.x)]) == gen, bar);
      __builtin_amdgcn_fence(__ATOMIC_ACQUIRE, "agent");
      asm volatile("s_waitcnt vmcnt(0)" ::: "memory");
    }
  }
  __syncthreads();
}

struct Params {
  const float* in[43];
  float* out;
  long o_ys, o_pak, o_pav, o_pbk, o_pbv, o_pckv, o_pckpe, o_pmk, o_pmv, o_sak, o_sav, o_sbk, o_sbv, o_sckv, o_sckpe;
  bf16_t *Wgu1, *Wd1, *Win, *Wuq, *Wukv, *Wukvu, *Wout, *Wmq, *Wmkv, *Wmo, *Wgu2, *Wd2;
  bf16_t *Xb, *H, *OMIX, *OM, *QA, *QB, *QC, *QM, *CQraw, *CKVraw;
  bf16_t *PKA, *PVA, *PKB, *PVB, *PKC, *PVC;
  bf16_t *SKA, *SVA, *SKB, *SVB, *SKC, *SVC, *SKM, *SVM;
  bf16_t *MK, *MV, *MEMb, *CCKVb;
  float *ss, *memss, *cqss, *ckvss, *KPE, *OB0;
  unsigned* bar; unsigned* bflag; unsigned* actr;
  float lam_init[4];
};

DI float sumsq64(const float (&v)[64]) { float s = 0.f;
#pragma unroll
  for (int i = 0; i < 64; ++i) s += v[i] * v[i];
  return s; }
DI void store_bf16_64(bf16_t* dst, const float (&v)[64]) {
#pragma unroll
  for (int c = 0; c < 8; ++c) { u32x4 w; w.x = pk2(v[8 * c], v[8 * c + 1]); w.y = pk2(v[8 * c + 2], v[8 * c + 3]); w.z = pk2(v[8 * c + 4], v[8 * c + 5]); w.w = pk2(v[8 * c + 6], v[8 * c + 7]); *(u32x4*)(dst + 8 * c) = w; } }
DI void store_bf16_32(bf16_t* dst, const float (&v)[64]) {
#pragma unroll
  for (int c = 0; c < 4; ++c) { u32x4 w; w.x = pk2(v[8 * c], v[8 * c + 1]); w.y = pk2(v[8 * c + 2], v[8 * c + 3]); w.z = pk2(v[8 * c + 4], v[8 * c + 5]); w.w = pk2(v[8 * c + 6], v[8 * c + 7]); *(u32x4*)(dst + 8 * c) = w; } }
DI void store_f32_64(float* dst, const float (&v)[64]) {
#pragma unroll
  for (int c = 0; c < 16; ++c) { f32x4 w = {v[4 * c], v[4 * c + 1], v[4 * c + 2], v[4 * c + 3]}; *(f32x4*)(dst + 4 * c) = w; } }
DI void mulgain64(float (&v)[64], const float* g, float sc) {
#pragma unroll
  for (int c = 0; c < 16; ++c) { f32x4 w = *(const f32x4*)(g + 4 * c); v[4 * c] *= w.x * sc; v[4 * c + 1] *= w.y * sc; v[4 * c + 2] *= w.z * sc; v[4 * c + 3] *= w.w * sc; } }
DI void scale64(float (&v)[64], float sc) {
#pragma unroll
  for (int i = 0; i < 64; ++i) v[i] *= sc; }
DI float rstd_from(const float* ssp, int np, int stride, int row, float invn) { float s = 0.f; for (int q = 0; q < np; ++q) s += ssp[(size_t)q * stride + row]; return rsqrtf(s * invn + EPS); }
DI void rope32(float (&v)[64], int pos) {
  const float fp = (float)pos;
#pragma unroll
  for (int i = 0; i < 16; ++i) {
    const float inv = ((i & 3) == 0 ? 1.f : (i & 3) == 1 ? 0.5623413251903491f : (i & 3) == 2 ? 0.31622776601683794f : 0.17782794100389228f)
                    * ((i >> 2) == 0 ? 1.f : (i >> 2) == 1 ? 0.1f : (i >> 2) == 2 ? 0.01f : 0.001f);
    const float ang = fp * inv;
    float rev = ang * 0.15915494309189535f; rev -= floorf(rev);
    const float c = __builtin_amdgcn_cosf(rev), s = __builtin_amdgcn_sinf(rev);
    const float x1 = v[i], x2 = v[16 + i]; v[i] = x1 * c - x2 * s; v[16 + i] = x1 * s + x2 * c; } }

typedef int i32x4 __attribute__((ext_vector_type(4)));
DI int lds_byte2(int r, int c) { const int st = (r >> 4) * 2 + (c >> 5), ob = (r & 15) * 64 + (c & 31) * 2; return st * 1024 + (ob ^ (((ob >> 9) & 1) << 5)); }
DI void stage_rc2(int b, int& Rr, int& Cc) { const int st = b >> 10, sb = b & 1023, swz = sb ^ (((sb >> 9) & 1) << 5); Rr = (st >> 1) * 16 + swz / 64; Cc = (st & 1) * 32 + (swz % 64) / 2; }
constexpr int G_TILE_B = 256 * 64 * 2, G_STAGE_B = 2 * G_TILE_B;

template <int MT, class Epi>
DI void gemm_unit(char* smem, const bf16_t* __restrict__ A, int lda, const bf16_t* __restrict__ Bt, int ldb, int K, int row0, int col0, Epi epi) {
  const int tid = ltid(), wid = tid >> 6, lane = tid & 63, wr = wid >> 2, wc = wid & 3, fr = lane & 15, fq = lane >> 4;
  constexpr int GLA = MT / 2, GLB = 4;
  const bf16_t* Ab = A + (size_t)row0 * lda;
  const bf16_t* Bb = Bt + (size_t)col0 * ldb;
  int aoff[GLA], boff[GLB];
#pragma unroll
  for (int i = 0; i < GLA; ++i) { int rr, cc; stage_rc2(wid * 1024 + i * 8192 + lane * 16, rr, cc); aoff[i] = rr * lda + cc; }
#pragma unroll
  for (int i = 0; i < GLB; ++i) { int rr, cc; stage_rc2(wid * 1024 + i * 8192 + lane * 16, rr, cc); boff[i] = rr * ldb + cc; }
  f32x4 acc[MT][4];
#pragma unroll
  for (int m = 0; m < MT; ++m)
#pragma unroll
    for (int n = 0; n < 4; ++n) acc[m][n] = (f32x4){0.f, 0.f, 0.f, 0.f};
  i32x4 sa[GLA], sb[GLB];
#define U_SA(b) (smem + (b) * G_STAGE_B)
#define U_SB(b) (smem + (b) * G_STAGE_B + G_TILE_B)
#define U_ISSUE(kt) do { _Pragma("unroll") for (int i = 0; i < GLA; ++i) sa[i] = *(const i32x4*)(Ab + aoff[i] + (kt) * 64); \
    _Pragma("unroll") for (int i = 0; i < GLB; ++i) sb[i] = *(const i32x4*)(Bb + boff[i] + (kt) * 64); __builtin_amdgcn_sched_barrier(0); } while (0)
#define U_WRITE(buf) do { _Pragma("unroll") for (int i = 0; i < GLA; ++i) *(i32x4*)(U_SA(buf) + wid * 1024 + i * 8192 + lane * 16) = sa[i]; \
    _Pragma("unroll") for (int i = 0; i < GLB; ++i) *(i32x4*)(U_SB(buf) + wid * 1024 + i * 8192 + lane * 16) = sb[i]; } while (0)
#define U_RDA(m, buf, ks) (*(const bf16x8*)(U_SA(buf) + lds_byte2(wr * 16 * MT + (m) * 16 + fr, (ks) * 32 + fq * 8)))
#define U_MM(m, AR, BF) do { _Pragma("unroll") for (int n = 0; n < 4; ++n) acc[m][n] = __builtin_amdgcn_mfma_f32_16x16x32_bf16(BF[n], AR, acc[m][n], 0, 0, 0); } while (0)
#define U_SBAR __builtin_amdgcn_sched_barrier(0)
#define U_RDB(BF, buf, ks) do { _Pragma("unroll") for (int n = 0; n < 4; ++n) BF[n] = *(const bf16x8*)(U_SB(buf) + lds_byte2(wc * 64 + n * 16 + fr, (ks) * 32 + fq * 8)); } while (0)
#define U_KTILE(buf) do { bf16x8 Bf[4], Bg[4], A0, A1; \
    U_RDB(Bf, buf, 0); A0 = U_RDA(0, buf, 0); \
    _Pragma("unroll") for (int m = 0; m < MT; m += 2) { \
      A1 = U_RDA(m + 1, buf, 0); U_SBAR; U_MM(m, A0, Bf); U_SBAR; \
      if (m + 2 < MT) { A0 = U_RDA(m + 2, buf, 0); } else { U_RDB(Bg, buf, 1); A0 = U_RDA(0, buf, 1); } U_SBAR; U_MM(m + 1, A1, Bf); U_SBAR; } \
    _Pragma("unroll") for (int m = 0; m < MT; m += 2) { \
      A1 = U_RDA(m + 1, buf, 1); U_SBAR; U_MM(m, A0, Bg); U_SBAR; \
      if (m + 2 < MT) A0 = U_RDA(m + 2, buf, 1); U_SBAR; U_MM(m + 1, A1, Bg); U_SBAR; } } while (0)
  const int nt = K >> 6;
  float* rtab = (float*)(smem + 2 * G_STAGE_B);
  if constexpr (Epi::NEED_RSTD) { if (tid < 32 * MT) rtab[tid] = rstd_from(epi.ss, 16, R, row0 + tid, 1.f / 1024.f); }
  U_ISSUE(0); U_WRITE(0); U_ISSUE(1); __syncthreads();
#pragma unroll 1
  for (int t = 0; t < nt; ++t) { const int cur = t & 1;
    if (t + 1 < nt) U_WRITE(cur ^ 1);
    if (t + 2 < nt) U_ISSUE(t + 2);
    U_KTILE(cur);
    __syncthreads(); }
#undef U_SA
#undef U_SB
#undef U_ISSUE
#undef U_WRITE
#undef U_KTILE
#undef U_RDB
#undef U_RDA
#undef U_MM
#undef U_SBAR
  if constexpr (Epi::DIRECT) {
    epi.template direct<MT>(acc, row0, wr * 16 * MT, col0 + wc * 64, fr, fq, rtab);
    __syncthreads();
  } else {
    static_assert(MT <= 4, "LDS epilogue: the whole unit (<= 128 rows x 256 cols f32) is parked in LDS at once");
    float* Ct = (float*)smem;
#pragma unroll
    for (int m = 0; m < MT; ++m)
#pragma unroll
      for (int n = 0; n < 4; ++n) *(f32x4*)(Ct + (wr * 16 * MT + m * 16 + fr) * 272 + wc * 68 + n * 16 + fq * 4) = acc[m][n];
    __syncthreads();
    if (tid < 128 * MT) {
      const int row = tid >> 2, piece = tid & 3; float v[64];
      const float* src = Ct + row * 272 + piece * 68;
#pragma unroll
      for (int c = 0; c < 16; ++c) { const f32x4 t4 = *(const f32x4*)(src + 4 * c); v[4 * c] = t4.x; v[4 * c + 1] = t4.y; v[4 * c + 2] = t4.z; v[4 * c + 3] = t4.w; }
      epi.nt = (col0 >> 7) + (piece >> 1);
      epi(row0 + row, piece & 1, v);
    }
    __syncthreads();
  }
}

struct EpiFfnUp { const float* ss; bf16_t* H; int nt;
  static constexpr bool DIRECT = true, NEED_RSTD = true;
  template <int MT> DI void direct(const f32x4 (&acc)[MT][4], int row0, int lrow, int cbase, int fr, int fq, const float* rtab) const {
#pragma unroll
    for (int m = 0; m < MT; ++m) { const float rs = rtab[lrow + m * 16 + fr]; bf16_t* dst = H + (size_t)(row0 + lrow + m * 16 + fr) * DFF + (cbase >> 1) + fq * 4;
#pragma unroll
      for (int q = 0; q < 2; ++q) { float h[4];
#pragma unroll
        for (int j = 0; j < 4; ++j) { const float g = acc[m][2 * q][j] * rs, u = acc[m][2 * q + 1][j] * rs; h[j] = g * __builtin_amdgcn_rcpf(1.f + __expf(-g)) * u; }
        u32x2 w; w.x = pk2(h[0], h[1]); w.y = pk2(h[2], h[3]); *(u32x2*)(dst + q * 16) = w; } }
  }
  DI void operator()(int, int, float (&)[64]) const {} };

struct EpiResid { float* X; bf16_t* Xb; float* ss; int nt; float scale;
  static constexpr bool DIRECT = true, NEED_RSTD = false;
  template <int MT> DI void direct(const f32x4 (&acc)[MT][4], int row0, int lrow, int cbase, int fr, int fq, const float*) const {
#pragma unroll
    for (int m = 0; m < MT; ++m) { const int row = row0 + lrow + m * 16 + fr; float sq = 0.f;
      float* xp = X + (size_t)row * DM + cbase + fq * 4; bf16_t* bp = Xb + (size_t)row * DM + cbase + fq * 4;
#pragma unroll
      for (int n = 0; n < 4; ++n) { f32x4 x = *(const f32x4*)(xp + n * 16);
        x.x += scale * acc[m][n][0]; x.y += scale * acc[m][n][1]; x.z += scale * acc[m][n][2]; x.w += scale * acc[m][n][3];
        *(f32x4*)(xp + n * 16) = x; u32x2 w; w.x = pk2(x.x, x.y); w.y = pk2(x.z, x.w); *(u32x2*)(bp + n * 16) = w;
        sq += x.x * x.x + x.y * x.y + x.z * x.z + x.w * x.w; }
      sq += __shfl_xor(sq, 16); sq += __shfl_xor(sq, 32);
      if (fq == 0) ss[(size_t)(cbase >> 6) * R + row] = sq;
      if (m & 1) __builtin_amdgcn_sched_barrier(0); }
  }
  DI void operator()(int, int, float (&)[64]) const {} };

struct EpiProj { const Params* pp; int l; int nt;
  static constexpr bool DIRECT = false, NEED_RSTD = false;
  DI void operator()(int row, int half, float (&v)[64]) const {
    const Params& p = *pp;
    const bool samp = row >= RP; const int sr = row - RP; const int b = samp ? (sr >> 6) : (row >> 12); const int t = samp ? (sr & 63) : (row & 4095);
    scale64(v, rstd_from(p.ss, 16, R, row, 1.f / 1024.f));
    if (nt < 2) { const int head = 2 * nt + half; const float r2 = rsqrtf(sumsq64(v) * (1.f / 64.f) + EPS);
      mulgain64(v, p.in[17] + l * 64, r2 * 0.125f * LOG2E); store_bf16_64(p.QA + (size_t)row * 256 + head * 64, v);
    } else if (nt < 6) { const bool isk = nt < 4; const int head = 2 * (nt - (isk ? 2 : 4)) + half;
      if (isk) { const float r2 = rsqrtf(sumsq64(v) * (1.f / 64.f) + EPS); mulgain64(v, p.in[18] + l * 64, r2); }
      bf16_t* kb = isk ? (samp ? p.SKA : p.PKA) : (samp ? p.SVA : p.PVA);
      const size_t krow = samp ? ((size_t)(l * 8 + b) * 576 + 512 + t) : (size_t)row;
      store_bf16_64(kb + krow * 256 + head * 64, v);
      if (samp) store_f32_64(p.out + (isk ? p.o_sak : p.o_sav) + ((size_t)(l * 8 + b) * 64 + t) * 256 + head * 64, v);
      else if (t >= 3584) store_f32_64(p.out + (isk ? p.o_pak : p.o_pav) + ((size_t)(l * 4 + b) * 512 + (t - 3584)) * 256 + head * 64, v);
    } else if (nt < 10) { const int g = 2 * (nt - 6) + half; const float r2 = rsqrtf(sumsq64(v) * (1.f / 64.f) + EPS);
      mulgain64(v, p.in[20] + l * 64, r2 * 0.125f * LOG2E); store_bf16_64(p.QB + (size_t)row * 512 + g * 64, v);
    } else if (nt < 18) { const bool isk = nt < 14; const int col = isk ? (128 * (nt - 10) + 64 * half) : (128 * (nt - 14) + 64 * half);
      if (isk) { const float r2 = rsqrtf(sumsq64(v) * (1.f / 64.f) + EPS); mulgain64(v, p.in[21] + l * 64, r2); }
      bf16_t* kb = isk ? (samp ? p.SKB : p.PKB) : (samp ? p.SVB : p.PVB);
      const size_t krow = samp ? ((size_t)(l * 8 + b) * 2112 + 2048 + t) : (size_t)row;
      store_bf16_64(kb + krow * 512 + col, v);
      if (samp) store_f32_64(p.out + (isk ? p.o_sbk : p.o_sbv) + ((size_t)l * 512 + sr) * 512 + col, v);
      else store_f32_64(p.out + (isk ? p.o_pbk : p.o_pbv) + ((size_t)l * RP + row) * 512 + col, v);
    } else if (nt < 21) { const int col = 128 * (nt - 18) + 64 * half;
      store_bf16_64(p.CQraw + (size_t)row * 384 + col, v); p.cqss[(size_t)(2 * (nt - 18) + half) * R + row] = sumsq64(v);
    } else if (nt < 23) { const int col = 128 * (nt - 21) + 64 * half;
      store_bf16_64(p.CKVraw + (size_t)row * 256 + col, v); p.ckvss[(size_t)(2 * (nt - 21) + half) * R + row] = sumsq64(v);
      if (samp) store_f32_64(p.out + p.o_sckv + ((size_t)l * 512 + sr) * 256 + col, v);
      else store_f32_64(p.out + p.o_pckv + ((size_t)l * RP + row) * 256 + col, v);
    } else { if (half == 0) { rope32(v, samp ? 2048 + t : t);
        float* o = samp ? (p.out + p.o_sckpe + ((size_t)l * 512 + sr) * 32) : (p.out + p.o_pckpe + ((size_t)l * RP + row) * 32);
        float* kp = p.KPE + (size_t)row * 32;
#pragma unroll
        for (int c = 0; c < 8; ++c) { f32x4 w = {v[4 * c], v[4 * c + 1], v[4 * c + 2], v[4 * c + 3]}; *(f32x4*)(o + 4 * c) = w; *(f32x4*)(kp + 4 * c) = w; } } }
  } };

struct EpiQc { const Params* pp; int l; int nt;
  static constexpr bool DIRECT = false, NEED_RSTD = false;
  DI void operator()(int row, int half, float (&v)[64]) const {
    const Params& p = *pp; const int h = nt;
    const bool samp = row >= RP; const int sr = row - RP; const int t = samp ? (sr & 63) : (row & 4095);
    scale64(v, rstd_from(p.cqss, 6, R, row, 1.f / 384.f));
    float s;
    if (half) { rope32(v, samp ? 2048 + t : t); s = 0.f;
#pragma unroll
      for (int i = 0; i < 32; ++i) s += v[i] * v[i]; } else s = sumsq64(v);
    s += __shfl_xor(s, 1);
    const float r2 = rsqrtf(s * (1.f / 96.f) + EPS) * (0.10206207261596575f * LOG2E);
    const float* g = p.in[28] + l * 96 + half * 64; bf16_t* dst = p.QC + (size_t)row * 384 + h * 96 + half * 64;
    if (half == 0) { mulgain64(v, g, r2); store_bf16_64(dst, v); }
    else {
#pragma unroll
      for (int i = 0; i < 32; ++i) v[i] *= g[i] * r2;
      store_bf16_32(dst, v); }
  } };

struct EpiKv { const Params* pp; int l; int nt; int mode;
  static constexpr bool DIRECT = false, NEED_RSTD = false;
  DI void operator()(int row, int half, float (&v)[64]) const {
    const Params& p = *pp; const int h = nt;
    size_t krow; const float* kpe; float rs = 1.f;
    if (mode == 0) { const bool samp = row >= RP; const int sr = row - RP;
      krow = samp ? ((size_t)(l * 8 + (sr >> 6)) * 2112 + 2048 + (sr & 63)) : (size_t)row; kpe = p.KPE + (size_t)row * 32;
      rs = rstd_from(p.ckvss, 4, R, row, 1.f / 256.f);
      if (h == 0) {
        float* o = samp ? (p.out + p.o_sckv + ((size_t)l * 512 + sr) * 256) : (p.out + p.o_pckv + ((size_t)l * RP + row) * 256);
        const float* g = p.in[25] + l * 256;
        for (int c = 0; c < 32; ++c) { const int cc = half * 128 + 4 * c; f32x4 x = *(const f32x4*)(o + cc); const f32x4 gg = *(const f32x4*)(g + cc);
          x.x *= rs * gg.x; x.y *= rs * gg.y; x.z *= rs * gg.z; x.w *= rs * gg.w; *(f32x4*)(o + cc) = x; } }
    } else { const int b = row >> 11, pos = row & 2047; krow = (size_t)(l * 8 + b) * 2112 + pos; kpe = p.in[8] + ((size_t)(l * 8 + b) * 2048 + pos) * 32; }
    const bool tosamp = (mode == 1) || (row >= RP);
    scale64(v, rs);
    if (half == 0) { float kp[32]; float s = sumsq64(v);
#pragma unroll
      for (int c = 0; c < 8; ++c) { const f32x4 w = *(const f32x4*)(kpe + 4 * c); kp[4 * c] = w.x; kp[4 * c + 1] = w.y; kp[4 * c + 2] = w.z; kp[4 * c + 3] = w.w; s += w.x * w.x + w.y * w.y + w.z * w.z + w.w * w.w; }
      const float r2 = rsqrtf(s * (1.f / 96.f) + EPS); const float* g = p.in[29] + l * 96;
      mulgain64(v, g, r2);
      bf16_t* dst = (tosamp ? p.SKC : p.PKC) + krow * 384 + h * 96; store_bf16_64(dst, v);
#pragma unroll
      for (int c = 0; c < 4; ++c) { u32x4 w; w.x = pk2(kp[8 * c] * g[64 + 8 * c] * r2, kp[8 * c + 1] * g[65 + 8 * c] * r2); w.y = pk2(kp[8 * c + 2] * g[66 + 8 * c] * r2, kp[8 * c + 3] * g[67 + 8 * c] * r2);
        w.z = pk2(kp[8 * c + 4] * g[68 + 8 * c] * r2, kp[8 * c + 5] * g[69 + 8 * c] * r2); w.w = pk2(kp[8 * c + 6] * g[70 + 8 * c] * r2, kp[8 * c + 7] * g[71 + 8 * c] * r2); *(u32x4*)(dst + 64 + 8 * c) = w; }
    } else { store_bf16_64((tosamp ? p.SVC : p.PVC) + krow * 256 + h * 64, v); }
  } };

struct EpiMemQ { const Params* pp; int l; int nt;
  static constexpr bool DIRECT = false, NEED_RSTD = false;
  DI void operator()(int row, int half, float (&v)[64]) const {
    const Params& p = *pp; const int h = nt;
    scale64(v, rstd_from(p.ss, 16, R, row, 1.f / 1024.f));
    float s = sumsq64(v); s += __shfl_xor(s, 1);
    const float r2 = rsqrtf(s * (1.f / 128.f) + EPS) * (0.08838834764831845f * LOG2E);
    mulgain64(v, p.in[33] + l * 128 + half * 64, r2);
    store_bf16_64(p.QM + (size_t)row * 512 + h * 128 + half * 64, v);
  } };

struct EpiMemKV { const Params* pp; int l; int nt;
  static constexpr bool DIRECT = false, NEED_RSTD = false;
  DI void operator()(int row, int half, float (&v)[64]) const {
    const Params& p = *pp;
    scale64(v, rstd_from(p.memss, 16, 1024, row, 1.f / 1024.f));
    const size_t idx = ((size_t)l * 1024 + row) * 512 + (nt & 3) * 128 + half * 64;
    if (nt < 4) { float s = sumsq64(v); s += __shfl_xor(s, 1); const float r2 = rsqrtf(s * (1.f / 128.f) + EPS);
      mulgain64(v, p.in[37] + l * 128 + half * 64, r2); store_f32_64(p.out + p.o_pmk + idx, v); store_bf16_64(p.MK + idx, v);
    } else { store_f32_64(p.out + p.o_pmv + idx, v); store_bf16_64(p.MV + idx, v); }
  } };

typedef __attribute__((address_space(3))) const char* lds_cptr;
typedef short v4i16_t __attribute__((ext_vector_type(4)));
DI s16x4 vtr(const char* p) { return __builtin_bit_cast(s16x4, __builtin_amdgcn_ds_read_tr16_b64_v4i16((__attribute__((address_space(3))) v4i16_t*)(p))); }

constexpr int ATT_VOFF = 17408, ATT_STAGE = 17408 + 16384, ATT_TAB = 2 * ATT_STAGE;

template <int DQK, int DV, int MODE, bool PF = true>
DI void attn_core(char* smem, const bf16_t* Qrow, const bf16_t* __restrict__ Kb, int ldk, const bf16_t* __restrict__ Vb, int ldv,
                  int T0, int T1, int wlo, int whi, bool active, int qpos, int kpos0, float slope, f32x16 (&o)[DV / 32]) {
  const int tid = ltid(), lane = tid & 63, r32 = lane & 31, hi = lane >> 5;
  constexpr int KSTR = DQK * 2 + 16, KCH = DQK / 8, VCH = DV / 8, NKI = (64 * KCH + NTHR - 1) / NTHR, NVI = (64 * VCH + NTHR - 1) / NTHR, KTOT = 64 * KCH, VTOT = 64 * VCH, NKS = DQK / 16, NDH = DV / 32;
  bf16x8 qr[NKS];
#pragma unroll
  for (int ks = 0; ks < NKS; ++ks) { if (active) qr[ks] = *(const bf16x8*)(Qrow + ks * 16 + hi * 8); else qr[ks] = (bf16x8){0, 0, 0, 0, 0, 0, 0, 0}; }
#pragma unroll
  for (int d = 0; d < NDH; ++d)
#pragma unroll
    for (int i = 0; i < 16; ++i) o[d][i] = 0.f;
  float mhat = 0.f, lsum = 0.f;
  u32x4 kr[NKI], vr[NVI];
  int koff[NKI], voff[NVI]; int klds[NKI], vlds[NVI];
#pragma unroll
  for (int i = 0; i < NKI; ++i) { const int idx = min(tid + NTHR * i, KTOT - 1), key = idx / KCH, ch = idx % KCH; koff[i] = key * ldk + ch * 8; klds[i] = key * KSTR + ch * 16; }
#pragma unroll
  for (int i = 0; i < NVI; ++i) { const int idx = min(tid + NTHR * i, VTOT - 1), key = idx / VCH, ch = idx % VCH; voff[i] = key * ldv + ch * 8; vlds[i] = ATT_VOFF + (ch >> 2) * 4096 + key * 64 + (ch & 3) * 16; }
  const float* tab = (const float*)(smem + ATT_TAB);
  if (PF) {
    if (T0 < T1) {
#pragma unroll
      for (int i = 0; i < NKI; ++i) kr[i] = *(const u32x4*)(Kb + (size_t)T0 * 64 * ldk + koff[i]);
#pragma unroll
      for (int i = 0; i < NVI; ++i) vr[i] = *(const u32x4*)(Vb + (size_t)T0 * 64 * ldv + voff[i]);
#pragma unroll
      for (int i = 0; i < NKI; ++i) *(u32x4*)(smem + klds[i]) = kr[i];
#pragma unroll
      for (int i = 0; i < NVI; ++i) *(u32x4*)(smem + vlds[i]) = vr[i];
      if (T0 + 1 < T1) {
#pragma unroll
        for (int i = 0; i < NKI; ++i) kr[i] = *(const u32x4*)(Kb + (size_t)(T0 + 1) * 64 * ldk + koff[i]);
#pragma unroll
        for (int i = 0; i < NVI; ++i) vr[i] = *(const u32x4*)(Vb + (size_t)(T0 + 1) * 64 * ldv + voff[i]);
      }
    }
    __syncthreads();
#pragma unroll 1
    for (int t = T0; t < T1; ++t) {
      const int cur = (t - T0) & 1;
      const char* sbuf = smem + cur * ATT_STAGE;
      if (t + 1 < T1) {
        char* nb = smem + (cur ^ 1) * ATT_STAGE;
#pragma unroll
        for (int i = 0; i < NKI; ++i) *(u32x4*)(nb + klds[i]) = kr[i];
#pragma unroll
        for (int i = 0; i < NVI; ++i) *(u32x4*)(nb + vlds[i]) = vr[i];
      }
      if (t + 2 < T1) {
#pragma unroll
        for (int i = 0; i < NKI; ++i) kr[i] = *(const u32x4*)(Kb + (size_t)(t + 2) * 64 * ldk + koff[i]);
#pragma unroll
        for (int i = 0; i < NVI; ++i) vr[i] = *(const u32x4*)(Vb + (size_t)(t + 2) * 64 * ldv + voff[i]);
      }
  if (active && t >= wlo && t < whi) {
        f32x16 s0, s1;
#pragma unroll
        for (int i = 0; i < 16; ++i) { s0[i] = 0.f; s1[i] = 0.f; }
        const char* kp = sbuf + r32 * KSTR + hi * 16;
#pragma unroll
        for (int ks = 0; ks < NKS; ++ks) {
          const bf16x8 k0 = *(const bf16x8*)(kp + ks * 32), k1 = *(const bf16x8*)(kp + 32 * KSTR + ks * 32);
          s0 = MFMA32(k0, qr[ks], s0); s1 = MFMA32(k1, qr[ks], s1); }
        __builtin_amdgcn_sched_barrier(0);
        if (MODE != 0) {
          const int dbase = qpos - (kpos0 + 64 * t + 4 * hi); const float fdb = (float)dbase;
#pragma unroll
          for (int i = 0; i < 16; ++i) { const int d0 = dbase - ((i & 3) + 8 * (i >> 2)), d1 = d0 - 32;
            if (MODE == 1) { const int i0 = min(max(d0, -128), 128) + 128, i1 = min(max(d1, -128), 128) + 128; s0[i] += tab[i0]; s1[i] += tab[i1]; }
            else { s0[i] -= slope * fabsf(fdb - (float)((i & 3) + 8 * (i >> 2))); s1[i] -= slope * fabsf(fdb - (float)(32 + (i & 3) + 8 * (i >> 2))); } }
        }
        float mx = fmaxf(s0[0], s1[0]);
#pragma unroll
        for (int i = 1; i < 16; ++i) mx = fmaxf(mx, fmaxf(s0[i], s1[i]));
        mx = fmaxf(mx, __shfl_xor(mx, 32));
        if (t == wlo) mhat = mx;
        else { const float g = mx - mhat;
          if (__any(g > 8.f)) { const float dl = fmaxf(g, 0.f); mhat += dl; const float f = __builtin_amdgcn_exp2f(-dl); lsum *= f;
#pragma unroll
            for (int i = 0; i < 16; ++i) { const float fr = __shfl(f, crow(i, hi));
#pragma unroll
              for (int d = 0; d < NDH; ++d) o[d][i] *= fr; } } }
        float ls = 0.f;
#pragma unroll
        for (int i = 0; i < 16; ++i) { s0[i] = __builtin_amdgcn_exp2f(s0[i] - mhat); s1[i] = __builtin_amdgcn_exp2f(s1[i] - mhat); ls += s0[i] + s1[i]; }
        lsum += ls;
        u32x4 pw[4];
#pragma unroll
        for (int c = 0; c < 4; ++c) { pw[0][c] = pk2(s0[2 * c], s0[2 * c + 1]); pw[1][c] = pk2(s0[8 + 2 * c], s0[9 + 2 * c]); pw[2][c] = pk2(s1[2 * c], s1[2 * c + 1]); pw[3][c] = pk2(s1[8 + 2 * c], s1[9 + 2 * c]); }
        __builtin_amdgcn_sched_barrier(0);
        const char* vp = sbuf + ATT_VOFF + ((lane >> 4) & 1) * 32 + (lane & 3) * 8 + (4 * hi + ((lane & 15) >> 2)) * 64;
#pragma unroll
        for (int s = 0; s < 4; ++s) {
          const bf16x8 pa = __builtin_bit_cast(bf16x8, pw[s]);
#pragma unroll
          for (int d = 0; d < NDH; ++d) {
            const s16x4 lo = vtr(vp + d * 4096 + s * 1024), hh = vtr(vp + d * 4096 + s * 1024 + 512);
            const bf16x8 vf = {lo[0], lo[1], lo[2], lo[3], hh[0], hh[1], hh[2], hh[3]};
            o[d] = MFMA32(pa, vf, o[d]); }
          __builtin_amdgcn_sched_barrier(0); }
      }
      __syncthreads();
    }
  } else {
#pragma unroll 1
    for (int t = T0; t < T1; ++t) {
#pragma unroll
      for (int i = 0; i < NKI; ++i) kr[i] = *(const u32x4*)(Kb + (size_t)t * 64 * ldk + koff[i]);
#pragma unroll
      for (int i = 0; i < NVI; ++i) vr[i] = *(const u32x4*)(Vb + (size_t)t * 64 * ldv + voff[i]);
      __syncthreads();
#pragma unroll
      for (int i = 0; i < NKI; ++i) *(u32x4*)(smem + klds[i]) = kr[i];
#pragma unroll
      for (int i = 0; i < NVI; ++i) *(u32x4*)(smem + vlds[i]) = vr[i];
      __syncthreads();
      const char* sbuf = smem;
  if (active && t >= wlo && t < whi) {
        f32x16 s0, s1;
#pragma unroll
        for (int i = 0; i < 16; ++i) { s0[i] = 0.f; s1[i] = 0.f; }
        const char* kp = sbuf + r32 * KSTR + hi * 16;
#pragma unroll
        for (int ks = 0; ks < NKS; ++ks) {
          const bf16x8 k0 = *(const bf16x8*)(kp + ks * 32), k1 = *(const bf16x8*)(kp + 32 * KSTR + ks * 32);
          s0 = MFMA32(k0, qr[ks], s0); s1 = MFMA32(k1, qr[ks], s1); }
        __builtin_amdgcn_sched_barrier(0);
        if (MODE != 0) {
          const int dbase = qpos - (kpos0 + 64 * t + 4 * hi); const float fdb = (float)dbase;
#pragma unroll
          for (int i = 0; i < 16; ++i) { const int d0 = dbase - ((i & 3) + 8 * (i >> 2)), d1 = d0 - 32;
            if (MODE == 1) { const int i0 = min(max(d0, -128), 128) + 128, i1 = min(max(d1, -128), 128) + 128; s0[i] += tab[i0]; s1[i] += tab[i1]; }
            else { s0[i] -= slope * fabsf(fdb - (float)((i & 3) + 8 * (i >> 2))); s1[i] -= slope * fabsf(fdb - (float)(32 + (i & 3) + 8 * (i >> 2))); } }
        }
        float mx = fmaxf(s0[0], s1[0]);
#pragma unroll
        for (int i = 1; i < 16; ++i) mx = fmaxf(mx, fmaxf(s0[i], s1[i]));
        mx = fmaxf(mx, __shfl_xor(mx, 32));
        if (t == wlo) mhat = mx;
        else { const float g = mx - mhat;
          if (__any(g > 8.f)) { const float dl = fmaxf(g, 0.f); mhat += dl; const float f = __builtin_amdgcn_exp2f(-dl); lsum *= f;
#pragma unroll
            for (int i = 0; i < 16; ++i) { const float fr = __shfl(f, crow(i, hi));
#pragma unroll
              for (int d = 0; d < NDH; ++d) o[d][i] *= fr; } } }
        float ls = 0.f;
#pragma unroll
        for (int i = 0; i < 16; ++i) { s0[i] = __builtin_amdgcn_exp2f(s0[i] - mhat); s1[i] = __builtin_amdgcn_exp2f(s1[i] - mhat); ls += s0[i] + s1[i]; }
        lsum += ls;
        u32x4 pw[4];
#pragma unroll
        for (int c = 0; c < 4; ++c) { pw[0][c] = pk2(s0[2 * c], s0[2 * c + 1]); pw[1][c] = pk2(s0[8 + 2 * c], s0[9 + 2 * c]); pw[2][c] = pk2(s1[2 * c], s1[2 * c + 1]); pw[3][c] = pk2(s1[8 + 2 * c], s1[9 + 2 * c]); }
        __builtin_amdgcn_sched_barrier(0);
        const char* vp = sbuf + ATT_VOFF + ((lane >> 4) & 1) * 32 + (lane & 3) * 8 + (4 * hi + ((lane & 15) >> 2)) * 64;
#pragma unroll
        for (int s = 0; s < 4; ++s) {
          const bf16x8 pa = __builtin_bit_cast(bf16x8, pw[s]);
#pragma unroll
          for (int d = 0; d < NDH; ++d) {
            const s16x4 lo = vtr(vp + d * 4096 + s * 1024), hh = vtr(vp + d * 4096 + s * 1024 + 512);
            const bf16x8 vf = {lo[0], lo[1], lo[2], lo[3], hh[0], hh[1], hh[2], hh[3]};
            o[d] = MFMA32(pa, vf, o[d]); }
          __builtin_amdgcn_sched_barrier(0); }
      }
    }
  }
  if (active) {
    lsum += __shfl_xor(lsum, 32);
    const float linv = 1.f / lsum;
#pragma unroll
    for (int i = 0; i < 16; ++i) { const float li = __shfl(linv, crow(i, hi));
#pragma unroll
      for (int d = 0; d < NDH; ++d) o[d][i] *= li; }
  }
}

template <int NDH>
DI void store_o(bf16_t* dst  , int ld, const f32x16 (&o)[NDH], int r32, int hi) {
#pragma unroll
  for (int i = 0; i < 16; ++i) { bf16_t* rp = dst + (size_t)crow(i, hi) * ld + r32;
#pragma unroll
    for (int d = 0; d < NDH; ++d) rp[32 * d] = (bf16_t)(pk2(o[d][i], 0.f) & 0xffffu); }
}

DI void attn_job(char* smem, const Params& p, int l, int kind, bool samp, int b, int h, int qt, int q) {
  const int tid = ltid(), lane = tid & 63, wid = tid >> 6, r32 = lane & 31, hi = lane >> 5, ch4 = wid >> 1;
  const int row0 = samp ? (RP + 64 * b) : (b * 4096 + 256 * qt);
  const int wrow = row0 + 32 * wid;
  const bool active = samp ? (wid < 2) : true;
  const int qpos = (samp ? 2048 : 256 * qt) + 32 * wid + r32;
  const int cq = 4 * qt + ch4;
  __syncthreads();
  if (kind == 0) {
    { float* tab = (float*)(smem + ATT_TAB); const float* src = p.in[19] + (size_t)(l * 4 + h) * 257; for (int i = tid; i < 257; i += NTHR) tab[i] = src[i] * LOG2E; }
    int T0, T1, wlo, whi, kpos0; const bf16_t *K, *V;
    if (samp) { T0 = 0; T1 = 9; wlo = 0; whi = 9; kpos0 = 1536; K = p.SKA + (size_t)(l * 8 + b) * 576 * 256 + h * 64; V = p.SVA + (size_t)(l * 8 + b) * 576 * 256 + h * 64; }
    else { T0 = max(0, 4 * qt - 8); T1 = 4 * qt + 4; wlo = max(0, cq - 8); whi = cq + 1; kpos0 = 0; K = p.PKA + (size_t)b * 4096 * 256 + h * 64; V = p.PVA + (size_t)b * 4096 * 256 + h * 64; }
    f32x16 o[2];
    attn_core<64, 64, 1>(smem, p.QA + (size_t)(wrow + r32) * 256 + h * 64, K, 256, V, 256, T0, T1, wlo, whi, active, qpos, kpos0, 0.f, o);
    if (active) store_o<2>(p.OMIX + (size_t)wrow * 1024 + h * 64, 1024, o, r32, hi);
  } else if (kind == 2) {
    const bf16_t *K, *V; int T1, whi;
    if (samp) { T1 = 33; whi = 33; K = p.SKC + (size_t)(l * 8 + b) * 2112 * 384 + h * 96; V = p.SVC + (size_t)(l * 8 + b) * 2112 * 256 + h * 64; }
    else { T1 = 4 * qt + 4; whi = cq + 1; K = p.PKC + (size_t)b * 4096 * 384 + h * 96; V = p.PVC + (size_t)b * 4096 * 256 + h * 64; }
    f32x16 o[2];
    attn_core<96, 64, 0>(smem, p.QC + (size_t)(wrow + r32) * 384 + h * 96, K, 384, V, 256, 0, T1, 0, whi, active, qpos, 0, 0.f, o);
    if (active) store_o<2>(p.OMIX + (size_t)wrow * 1024 + 768 + h * 64, 1024, o, r32, hi);
  } else {
    const bf16_t *K, *V; int T1, whi;
    if (samp) { T1 = 33; whi = 33; K = p.SKB + (size_t)(l * 8 + b) * 2112 * 512; V = p.SVB + (size_t)(l * 8 + b) * 2112 * 512 + h * 128; }
    else { T1 = 4 * qt + 4; whi = cq + 1; K = p.PKB + (size_t)b * 4096 * 512; V = p.PVB + (size_t)b * 4096 * 512 + h * 128; }
    const float slope = exp2f(-2.f * (float)(h + 1)) * LOG2E;
    const int jj = (kind == 3) ? 1 : 0;
    f32x16 o[4];
    attn_core<64, 128, 2>(smem, p.QB + (size_t)(wrow + r32) * 512 + (h * 2 + jj) * 64, K + (h * 2 + jj) * 64, 512, V, 512, 0, T1, 0, whi, active, qpos, 0, slope, o);
    float* ob = p.OB0 + (size_t)wrow * 512 + h * 128 + r32;
    unsigned* flag = p.bflag + l * NAJ + q;
    if (jj == 0) {
      if (active) {
#pragma unroll
        for (int i = 0; i < 16; ++i)
#pragma unroll
          for (int d = 0; d < 4; ++d) ob[(size_t)crow(i, hi) * 512 + 32 * d] = o[d][i];
      }
      asm volatile("s_waitcnt vmcnt(0)" ::: "memory");
      __syncthreads();
      if (tid == 0) { __builtin_amdgcn_fence(__ATOMIC_RELEASE, "agent"); asm volatile("s_waitcnt vmcnt(0)" ::: "memory");
        __hip_atomic_store(flag, 1u, __ATOMIC_RELAXED, __HIP_MEMORY_SCOPE_AGENT); }
    } else {
      float lam;
      { const float* bl = p.in[22] + (size_t)l * 256; float p1 = bl[lane] * bl[64 + lane], p2 = bl[128 + lane] * bl[192 + lane];
#pragma unroll
        for (int m = 1; m < 64; m <<= 1) { p1 += __shfl_xor(p1, m); p2 += __shfl_xor(p2, m); }
        lam = expf(p1) - expf(p2) + p.lam_init[l]; }
      if (tid == 0) { unsigned sp = 0u; while (__hip_atomic_load(flag, __ATOMIC_RELAXED, __HIP_MEMORY_SCOPE_AGENT) == 0u && ++sp < (1u << 20)) __builtin_amdgcn_s_sleep(2);
        __builtin_amdgcn_fence(__ATOMIC_ACQUIRE, "agent"); asm volatile("s_waitcnt vmcnt(0)" ::: "memory"); }
      __syncthreads();
      if (active) {
        const float* gsub = p.in[23] + l * 128; const float omz = 1.f - p.lam_init[l];
#pragma unroll
        for (int i = 0; i < 16; ++i)
#pragma unroll
          for (int d = 0; d < 4; ++d) o[d][i] = ob[(size_t)crow(i, hi) * 512 + 32 * d] - lam * o[d][i];
#pragma unroll
        for (int i = 0; i < 16; ++i) { float sq = o[0][i] * o[0][i] + o[1][i] * o[1][i] + o[2][i] * o[2][i] + o[3][i] * o[3][i];
          sq += __shfl_xor(sq, 1); sq += __shfl_xor(sq, 2); sq += __shfl_xor(sq, 4); sq += __shfl_xor(sq, 8); sq += __shfl_xor(sq, 16);
          const float r2 = rsqrtf(sq * (1.f / 128.f) + EPS) * omz;
#pragma unroll
          for (int d = 0; d < 4; ++d) o[d][i] *= r2 * gsub[32 * d + r32]; }
        store_o<4>(p.OMIX + (size_t)wrow * 1024 + 256 + h * 128, 1024, o, r32, hi);
      }
    }
  }
}

DI void mem_attn(char* smem, const Params& p, int l, int row0, int nrows, int h, const bf16_t* K, const bf16_t* V) {
  const int tid = ltid(), lane = tid & 63, wid = tid >> 6, r32 = lane & 31, hi = lane >> 5;
  const bool active = 32 * wid < nrows; const int wrow = row0 + 32 * wid;
  f32x16 o[4];
  __syncthreads();
  attn_core<128, 128, 0, false>(smem, p.QM + (size_t)(wrow + r32) * 512 + h * 128, K + h * 128, 512, V + h * 128, 512, 0, 4, 0, 4, active, 0, 0, 0.f, o);
  if (active) store_o<4>(p.OM + (size_t)wrow * 512 + h * 128, 512, o, r32, hi);
}

constexpr int WT_PER_LAYER = 352 * 2 + 176 * 2 + 192 + 12 + 8 + 8 + 64 + 32 + 64 + 32;
DI void wt_job(char* smem, const Params& p, int job) {
  const int l = job / WT_PER_LAYER; int r = job % WT_PER_LAYER;
  bf16_t* dst; int K, ntk, map; const float* gain = nullptr; const float* s0; const float* s1 = nullptr; int ldsrc;
  if (r < 352) { dst = p.Wgu1 + (size_t)l * 5632 * 1024; K = 1024; map = 1; gain = p.in[11] + l * 1024; s0 = p.in[12] + (size_t)l * 1024 * 2816; s1 = p.in[13] + (size_t)l * 1024 * 2816; ldsrc = 2816; }
  else if ((r -= 352) < 176) { dst = p.Wd1 + (size_t)l * 1024 * 2816; K = 2816; map = 0; s0 = p.in[14] + (size_t)l * 2816 * 1024; ldsrc = 1024; }
  else if ((r -= 176) < 192) { dst = p.Win + (size_t)l * 3072 * 1024; K = 1024; map = 0; gain = p.in[15] + l * 1024; s0 = p.in[16] + (size_t)l * 1024 * 2976; ldsrc = 2976; }
  else if ((r -= 192) < 12) { dst = p.Wuq + (size_t)l * 512 * 384; K = 384; map = 2; gain = p.in[24] + l * 384; s0 = p.in[26] + (size_t)l * 384 * 384; ldsrc = 384; }
  else if ((r -= 12) < 8) { dst = p.Wukv + (size_t)l * 512 * 256; K = 256; map = 0; gain = p.in[25] + l * 256; s0 = p.in[27] + (size_t)l * 256 * 512; ldsrc = 512; }
  else if ((r -= 8) < 8) { dst = p.Wukvu + (size_t)l * 512 * 256; K = 256; map = 0; s0 = p.in[27] + (size_t)l * 256 * 512; ldsrc = 512; }
  else if ((r -= 8) < 64) { dst = p.Wout + (size_t)l * 1024 * 1024; K = 1024; map = 0; s0 = p.in[30] + (size_t)l * 1024 * 1024; ldsrc = 1024; }
  else if ((r -= 64) < 32) { dst = p.Wmq + (size_t)l * 512 * 1024; K = 1024; map = 0; gain = p.in[31] + l * 1024; s0 = p.in[32] + (size_t)l * 1024 * 512; ldsrc = 512; }
  else if ((r -= 32) < 64) { dst = p.Wmkv + (size_t)l * 1024 * 1024; K = 1024; map = 3; gain = p.in[34] + l * 1024; s0 = p.in[35] + (size_t)l * 1024 * 512; s1 = p.in[36] + (size_t)l * 1024 * 512; ldsrc = 512; }
  else if ((r -= 64) < 32) { dst = p.Wmo + (size_t)l * 1024 * 512; K = 512; map = 0; s0 = p.in[38] + (size_t)l * 512 * 1024; ldsrc = 1024; }
  else if ((r -= 32) < 352) { dst = p.Wgu2 + (size_t)l * 5632 * 1024; K = 1024; map = 1; gain = p.in[39] + l * 1024; s0 = p.in[40] + (size_t)l * 1024 * 2816; s1 = p.in[41] + (size_t)l * 1024 * 2816; ldsrc = 2816; }
  else { r -= 352; dst = p.Wd2 + (size_t)l * 1024 * 2816; K = 2816; map = 0; s0 = p.in[42] + (size_t)l * 2816 * 1024; ldsrc = 1024; }
  ntk = K >> 6;
  const int n0 = (r / ntk) * 256, k0 = (r % ntk) * 64;
  const int tid = ltid();
  float* lf = (float*)smem;
  { const int c4 = tid & 63, kq = tid >> 6; const int np = n0 + 4 * c4; const float* src = s0; int col;
    if (map == 0) col = np < ldsrc ? np : -1;
    else if (map == 1) { const int w = np & 63, sub = w >> 4; col = (np >> 6) * 32 + (sub >> 1) * 16 + (w & 15); if (sub & 1) src = s1; }
    else if (map == 2) { col = (np & 127) < 96 ? (np >> 7) * 96 + (np & 127) : -1; }
    else { if (np < 512) col = np; else { col = np - 512; src = s1; } }
#pragma unroll
    for (int i = 0; i < 8; ++i) { const int kl = kq + 8 * i; f32x4 x = {0.f, 0.f, 0.f, 0.f};
      if (col >= 0) { x = *(const f32x4*)(src + (size_t)(k0 + kl) * ldsrc + col); if (gain) { const float g = gain[k0 + kl]; x.x *= g; x.y *= g; x.z *= g; x.w *= g; } }
      *(f32x4*)(lf + kl * 260 + 4 * c4) = x; } }
  __syncthreads();
  { const int nl = tid >> 1, kh = (tid & 1) * 32; float x[32];
#pragma unroll
    for (int j = 0; j < 32; ++j) x[j] = lf[(kh + j) * 260 + nl];
    bf16_t* d = dst + (size_t)(n0 + nl) * K + k0 + kh;
#pragma unroll
    for (int c = 0; c < 4; ++c) { u32x4 w = {pk2(x[8 * c], x[8 * c + 1]), pk2(x[8 * c + 2], x[8 * c + 3]), pk2(x[8 * c + 4], x[8 * c + 5]), pk2(x[8 * c + 6], x[8 * c + 7])}; *(u32x4*)(d + 8 * c) = w; } }
  __syncthreads();
}

DI void rowprep_job(const Params& p, int job, bool mem) {
  const int tid = ltid(), lane = tid & 63, wid = tid >> 6; const int row = 8 * job + wid;
  const float* src = mem ? (p.in[2] + (size_t)row * DM) : (row < RP ? p.in[0] + (size_t)row * DM : p.in[1] + (size_t)(row - RP) * DM);
  f32x4 x[4]; float s = 0.f;
#pragma unroll
  for (int c = 0; c < 4; ++c) { x[c] = *(const f32x4*)(src + lane * 16 + 4 * c); s += x[c].x * x[c].x + x[c].y * x[c].y + x[c].z * x[c].z + x[c].w * x[c].w; }
  if (!mem) {
#pragma unroll
    for (int c = 0; c < 4; ++c) *(f32x4*)(p.out + (size_t)row * DM + lane * 16 + 4 * c) = x[c]; }
  bf16_t* d = (mem ? p.MEMb : p.Xb) + (size_t)row * DM + lane * 16;
  u32x4 w0 = {pk2(x[0].x, x[0].y), pk2(x[0].z, x[0].w), pk2(x[1].x, x[1].y), pk2(x[1].z, x[1].w)}, w1 = {pk2(x[2].x, x[2].y), pk2(x[2].z, x[2].w), pk2(x[3].x, x[3].y), pk2(x[3].z, x[3].w)};
  *(u32x4*)d = w0; *(u32x4*)(d + 8) = w1;
  s += __shfl_xor(s, 1); s += __shfl_xor(s, 2);
  if ((lane & 3) == 0) { if (mem) p.memss[(size_t)(lane >> 2) * 1024 + row] = s; else p.ss[(size_t)(lane >> 2) * R + row] = s; }
}

DI void conv_job(const float* src, bf16_t* dst, int job, int chunk, int dstride) {
  const size_t e = (size_t)job * 4096 + ltid() * 8;
  const f32x4 a = *(const f32x4*)(src + e), b = *(const f32x4*)(src + e + 4);
  u32x4 w = {pk2(a.x, a.y), pk2(a.z, a.w), pk2(b.x, b.y), pk2(b.z, b.w)};
  const size_t q = e / (size_t)chunk, rm = e % (size_t)chunk;
  *(u32x4*)(dst + q * (size_t)dstride + rm) = w;
}


DI void gemm_decode(int j, int MT, int NT, int& m, int& n) {
  const int rowsz = 8 * NT, sm = j / rowsz, jr = j - sm * rowsz, rows = min(8, MT - 8 * sm), nfull = NT >> 3, blk = rows * 8;
  int sn, w, local;
  if (jr < nfull * blk) { sn = jr / blk; w = 8; local = jr - sn * blk; } else { sn = nfull; w = NT - 8 * nfull; local = jr - nfull * blk; }
  const int mi = local / w; m = 8 * sm + mi; n = 8 * sn + (local - mi * w); }
DI bool gemm_job(int it, int MT, int NT, int& m, int& n) {
  const int G = gridDim.x, bid = blockIdx.x, per = G >> 3;
  if (it >= (MT * NT) / G) return false;
  gemm_decode((it * 8 + (bid & 7)) * per + (bid >> 3), MT, NT, m, n); return true; }
DI bool gemm_tail(int it, int MT, int NT, int& m, int& n, int& half) {
  const int G = gridDim.x, t = blockIdx.x + it * G, tot = MT * NT, base = (tot / G) * G, L = tot - base;
  if (t >= 2 * L) return false;
  gemm_decode(base + (t >> 1), MT, NT, m, n); half = t & 1; return true; }

template <int SEL>
DI void run_phase(const Params& p, char* smem, int ph) {
  const int G = gridDim.x, bid = blockIdx.x;
#ifdef ONLY_S
  if (ph < 2 && ONLY_S < 10) return;
  if (ph >= 2 && ONLY_S >= 10) return;
#endif
  if (ph == 0) {
    constexpr int NWT = WT_PER_LAYER * NL;
    constexpr int J1 = NWT, J2 = J1 + R / 8, J3 = J2 + 128, J4 = J3 + 1024, J5 = J4 + 1024, J6 = J5 + 8192, J7 = J6 + 8192, J8 = J7 + 1024, J9 = J8 + 1024, J10 = J9 + 4096;
    for (int j = bid; j < J10; j += G) {
      if (j < J1) wt_job(smem, p, j);
      else if (j < J2) rowprep_job(p, j - J1, false);
      else if (j < J3) rowprep_job(p, j - J2, true);
      else if (j < J4) conv_job(p.in[3], p.SKA, j - J3, 512 * 256, 576 * 256);
      else if (j < J5) conv_job(p.in[4], p.SVA, j - J4, 512 * 256, 576 * 256);
      else if (j < J6) conv_job(p.in[5], p.SKB, j - J5, 2048 * 512, 2112 * 512);
      else if (j < J7) conv_job(p.in[6], p.SVB, j - J6, 2048 * 512, 2112 * 512);
      else if (j < J8) conv_job(p.in[9], p.SKM, j - J7, 256 * 512, 256 * 512);
      else if (j < J9) conv_job(p.in[10], p.SVM, j - J8, 256 * 512, 256 * 512);
      else conv_job(p.in[7], p.CCKVb, j - J9, 2048 * 256, 2048 * 256);
    }
    return;
  }
  if (ph == 1) {
    if (G != 256) {
      for (int j = bid; j < 128 + 1024; j += G) {
        if (j < 128) { const int l = j >> 5, m = (j >> 2) & 7, n = j & 3;
          gemm_unit<4>(smem, p.MEMb, 1024, p.Wmkv + (size_t)l * 1024 * 1024, 1024, 1024, m * 128, n * 256, EpiMemKV{&p, l, 0});
        } else { const int q = j - 128, l = q >> 8, m = (q >> 1) & 127, n = q & 1;
          gemm_unit<4>(smem, p.CCKVb + (size_t)l * 16384 * 256, 256, p.Wukvu + (size_t)l * 512 * 256, 256, 256, m * 128, n * 256, EpiKv{&p, l, 0, 1}); } }
      return; }
    if (bid < 128) { const int l = bid >> 5, m = (bid >> 2) & 7, n = bid & 3;
      gemm_unit<4>(smem, p.MEMb, 1024, p.Wmkv + (size_t)l * 1024 * 1024, 1024, 1024, m * 128, n * 256, EpiMemKV{&p, l, 0}); }
    const int nq = bid < 128 ? 3 : 5, q0 = bid < 128 ? bid : 384 + (bid - 128);
    for (int k = 0; k < nq; ++k) { const int q = q0 + 128 * k, l = q >> 8, m = (q >> 1) & 127, n = q & 1;
      gemm_unit<4>(smem, p.CCKVb + (size_t)l * 16384 * 256, 256, p.Wukvu + (size_t)l * 512 * 256, 256, 256, m * 128, n * 256, EpiKv{&p, l, 0, 1}); }
    return;
  }
  const int l = (ph - 2) / 10, s = (ph - 2) % 10;
#ifdef ONLY_S
  if (s != ONLY_S) return;
#endif
  if (s == 0 || s == 8) {
    const bf16_t* W = p.Wgu1 + (size_t)((s == 0 ? 0 : NL) + l) * 5632 * 1024;
    for (int it = 0;; ++it) { int m, n; if (!gemm_job(it, 66, 22, m, n)) break;
      gemm_unit<8>(smem, p.Xb, 1024, W, 1024, 1024, m * 256, n * 256, EpiFfnUp{p.ss, p.H, 0}); }
    for (int it = 0;; ++it) { int m, n, hf; if (!gemm_tail(it, 66, 22, m, n, hf)) break;
      gemm_unit<4>(smem, p.Xb, 1024, W, 1024, 1024, m * 256 + 128 * hf, n * 256, EpiFfnUp{p.ss, p.H, 0}); }
  } else if (s == 1 || s == 9) {
    const bf16_t* W = p.Wd1 + (size_t)((s == 1 ? 0 : NL) + l) * 1024 * 2816;
    for (int j = bid; j < 256; j += G) gemm_unit<8>(smem, p.H, DFF, W, DFF, DFF, (j >> 2) * 256, (j & 3) * 256, EpiResid{p.out, p.Xb, p.ss, 0, 0.5f});
    for (int t = bid; t < 32; t += G) gemm_unit<2>(smem, p.H, DFF, W, DFF, DFF, RP + 64 * (t >> 2), (t & 3) * 256, EpiResid{p.out, p.Xb, p.ss, 0, 0.5f});
  } else if (s == 2) {
    const bf16_t* W = p.Win + (size_t)l * 3072 * 1024;
    for (int it = 0;; ++it) { int m, n; if (!gemm_job(it, 132, 12, m, n)) break;
      gemm_unit<4>(smem, p.Xb, 1024, W, 1024, 1024, m * 128, n * 256, EpiProj{&p, l, 0}); }
    for (int it = 0;; ++it) { int m, n, hf; if (!gemm_tail(it, 132, 12, m, n, hf)) break;
      gemm_unit<2>(smem, p.Xb, 1024, W, 1024, 1024, m * 128 + 64 * hf, n * 256, EpiProj{&p, l, 0}); }
  } else if (s == 3) {
    for (int j = bid; j < 128 * 4; j += G) { const int m = j >> 2, n = (j >> 1) & 1;
      if (j & 1) gemm_unit<4>(smem, p.CKVraw, 256, p.Wukv + (size_t)l * 512 * 256, 256, 256, m * 128, n * 256, EpiKv{&p, l, 0, 0});
      else gemm_unit<4>(smem, p.CQraw, 384, p.Wuq + (size_t)l * 512 * 384, 384, 384, m * 128, n * 256, EpiQc{&p, l, 0}); }
    for (int t = bid; t < 32; t += G) { const int r0 = RP + 64 * (t >> 2), n = (t >> 1) & 1;
      if (t & 1) gemm_unit<2>(smem, p.CKVraw, 256, p.Wukv + (size_t)l * 512 * 256, 256, 256, r0, n * 256, EpiKv{&p, l, 0, 0});
      else gemm_unit<2>(smem, p.CQraw, 384, p.Wuq + (size_t)l * 512 * 384, 384, 384, r0, n * 256, EpiQc{&p, l, 0}); }
  } else if (s == 4) {
    constexpr int NJ = 4 * NAJ;
    int* sj = (int*)(smem + 72000);
    for (;;) {
      __syncthreads();
      if (threadIdx.x == 0) *sj = (int)__hip_atomic_fetch_add(p.actr + l, 1u, __ATOMIC_RELAXED, __HIP_MEMORY_SCOPE_AGENT);
      __syncthreads();
      const int j = *sj; if (j >= NJ) break;
      const int grp = j / NAJ, q = j % NAJ; const int kind = grp == 0 ? 1 : (grp == 1 ? 3 : (grp == 2 ? 2 : 0));
      const bool sm = q >= 256;
      attn_job(smem, p, l, kind, sm, sm ? ((q - 256) >> 2) : ((q >> 2) & 3), q & 3, sm ? 0 : 15 - (q >> 4), q); }
  } else if (s == 5) {
    const bf16_t* W = p.Wout + (size_t)l * 1024 * 1024;
    for (int j = bid; j < 256; j += G) gemm_unit<8>(smem, p.OMIX, 1024, W, 1024, 1024, (j >> 2) * 256, (j & 3) * 256, EpiResid{p.out, p.Xb, p.ss, 0, 1.0f});
    for (int t = bid; t < 32; t += G) gemm_unit<2>(smem, p.OMIX, 1024, W, 1024, 1024, RP + 64 * (t >> 2), (t & 3) * 256, EpiResid{p.out, p.Xb, p.ss, 0, 1.0f});
  } else if (s == 6) {
    const bf16_t* W = p.Wmq + (size_t)l * 512 * 1024;
    for (int j = bid; j < 128 + 16; j += G) {
      if (j < 128) { const int m = j >> 1, n = j & 1, b = m >> 4;
        gemm_unit<4>(smem, p.Xb, 1024, W, 1024, 1024, m * 256, n * 256, EpiMemQ{&p, l, 0});
        gemm_unit<4>(smem, p.Xb, 1024, W, 1024, 1024, m * 256 + 128, n * 256, EpiMemQ{&p, l, 0});
        __threadfence(); __syncthreads();
        for (int u = 0; u < 2; ++u) mem_attn(smem, p, l, m * 256, 256, 2 * n + u, p.MK + (size_t)(l * 4 + b) * 256 * 512, p.MV + (size_t)(l * 4 + b) * 256 * 512);
      } else { const int sb = (j - 128) >> 1, n = j & 1;
        gemm_unit<2>(smem, p.Xb, 1024, W, 1024, 1024, RP + 64 * sb, n * 256, EpiMemQ{&p, l, 0});
        __threadfence(); __syncthreads();
        for (int u = 0; u < 2; ++u) mem_attn(smem, p, l, RP + 64 * sb, 64, 2 * n + u, p.SKM + (size_t)(l * 8 + sb) * 256 * 512, p.SVM + (size_t)(l * 8 + sb) * 256 * 512); }
    }
  } else if (s == 7) {
    const bf16_t* W = p.Wmo + (size_t)l * 1024 * 512;
    for (int j = bid; j < 256; j += G) gemm_unit<8>(smem, p.OM, 512, W, 512, 512, (j >> 2) * 256, (j & 3) * 256, EpiResid{p.out, p.Xb, p.ss, 0, 1.0f});
    for (int t = bid; t < 32; t += G) gemm_unit<2>(smem, p.OM, 512, W, 512, 512, RP + 64 * (t >> 2), (t & 3) * 256, EpiResid{p.out, p.Xb, p.ss, 0, 1.0f});
  }
}

__global__ void __launch_bounds__(NTHR, 2) mega(Params p, int ph_lo, int ph_hi) {
  __shared__ __attribute__((aligned(16))) char smem[LDS_BYTES];
  __shared__ uint4 xb_words;
  if (ph_hi < 0) { cg::this_grid().sync(); }
  if (threadIdx.x == 0) xb_words = make_uint4(0u, 0u, 0u, 0u);
  __syncthreads();
  XcdBarrier xb = xcd_barrier_post(p.bar, (volatile LAS unsigned*)&xb_words);
  for (int ph = ph_lo; ph < ph_hi; ++ph) {
    run_phase<-1>(p, smem, ph);
#if REP_UP
    if (ph >= 2 && ((ph - 2) % 10 == 0 || (ph - 2) % 10 == 8)) { xcd_barrier(xb); run_phase<-1>(p, smem, ph); }
#endif
#if REP_ATT
    if (ph >= 2 && ((ph - 2) % 10 == 4)) { xcd_barrier(xb); run_phase<-1>(p, smem, ph); }
#endif
    if (ph + 1 < ph_hi) xcd_barrier(xb);
#if REP_SYNC
    if (ph + 1 < ph_hi) xcd_barrier(xb);
#endif
  }
}

#ifndef MK_MULTI
#define MK_MULTI 0
#endif

extern "C" void kernel_launch(void* const* d_in, const int* in_sizes, int n_in, void* d_out, int out_size, void* d_ws, size_t ws_size, hipStream_t stream) {
  Params p; memset(&p, 0, sizeof(p));
  for (int i = 0; i < 43; ++i) p.in[i] = (const float*)d_in[i];
  p.out = (float*)d_out;
  long off = 0;
  auto take = [&](long n) { long o = off; off += n; return o; };
  take((long)RP * DM); p.o_ys = take(512L * DM);
  p.o_pak = take(4L * 4 * 512 * 256); p.o_pav = take(4L * 4 * 512 * 256);
  p.o_pbk = take(4L * RP * 512); p.o_pbv = take(4L * RP * 512);
  p.o_pckv = take(4L * RP * 256); p.o_pckpe = take(4L * RP * 32);
  p.o_pmk = take(4L * 4 * 256 * 512); p.o_pmv = take(4L * 4 * 256 * 512);
  p.o_sak = take(4L * 512 * 256); p.o_sav = take(4L * 512 * 256);
  p.o_sbk = take(4L * 512 * 512); p.o_sbv = take(4L * 512 * 512);
  p.o_sckv = take(4L * 512 * 256); p.o_sckpe = take(4L * 512 * 32);
  char* ws = (char*)d_ws; size_t wo = 0;
  auto alloc = [&](size_t bytes) { char* r = ws + wo; wo += (bytes + 255) & ~(size_t)255; return r; };
  p.Wgu1 = (bf16_t*)alloc((size_t)2 * NL * 5632 * 1024 * 2); p.Wd1 = (bf16_t*)alloc((size_t)2 * NL * 1024 * 2816 * 2);
  p.Wgu2 = p.Wgu1 + (size_t)NL * 5632 * 1024; p.Wd2 = p.Wd1 + (size_t)NL * 1024 * 2816;
  p.Win = (bf16_t*)alloc((size_t)NL * 3072 * 1024 * 2); p.Wuq = (bf16_t*)alloc((size_t)NL * 512 * 384 * 2);
  p.Wukv = (bf16_t*)alloc((size_t)NL * 512 * 256 * 2); p.Wukvu = (bf16_t*)alloc((size_t)NL * 512 * 256 * 2);
  p.Wout = (bf16_t*)alloc((size_t)NL * 1024 * 1024 * 2); p.Wmq = (bf16_t*)alloc((size_t)NL * 512 * 1024 * 2);
  p.Wmkv = (bf16_t*)alloc((size_t)NL * 1024 * 1024 * 2); p.Wmo = (bf16_t*)alloc((size_t)NL * 1024 * 512 * 2);
  p.Xb = (bf16_t*)alloc((size_t)R * 1024 * 2);
  const size_t ubase = wo;
  p.OMIX = (bf16_t*)alloc((size_t)R * 1024 * 2); p.QA = (bf16_t*)alloc((size_t)R * 256 * 2); p.QB = (bf16_t*)alloc((size_t)R * 512 * 2);
  p.QC = (bf16_t*)alloc((size_t)R * 384 * 2); p.CQraw = (bf16_t*)alloc((size_t)R * 384 * 2); p.CKVraw = (bf16_t*)alloc((size_t)R * 256 * 2);
  p.PKA = (bf16_t*)alloc((size_t)RP * 256 * 2); p.PVA = (bf16_t*)alloc((size_t)RP * 256 * 2);
  p.PKB = (bf16_t*)alloc((size_t)RP * 512 * 2); p.PVB = (bf16_t*)alloc((size_t)RP * 512 * 2);
  p.PKC = (bf16_t*)alloc((size_t)RP * 384 * 2); p.PVC = (bf16_t*)alloc((size_t)RP * 256 * 2);
  p.H = (bf16_t*)(ws + ubase);
  if (wo - ubase < (size_t)R * DFF * 2) wo = ubase + (size_t)R * DFF * 2;
  p.OM = (bf16_t*)alloc((size_t)R * 512 * 2); p.QM = (bf16_t*)alloc((size_t)R * 512 * 2);
  p.SKA = (bf16_t*)alloc((size_t)NL * 8 * 576 * 256 * 2); p.SVA = (bf16_t*)alloc((size_t)NL * 8 * 576 * 256 * 2);
  p.SKB = (bf16_t*)alloc((size_t)NL * 8 * 2112 * 512 * 2); p.SVB = (bf16_t*)alloc((size_t)NL * 8 * 2112 * 512 * 2);
  p.SKC = (bf16_t*)alloc((size_t)NL * 8 * 2112 * 384 * 2); p.SVC = (bf16_t*)alloc((size_t)NL * 8 * 2112 * 256 * 2);
  p.SKM = (bf16_t*)alloc((size_t)NL * 8 * 256 * 512 * 2); p.SVM = (bf16_t*)alloc((size_t)NL * 8 * 256 * 512 * 2);
  p.MK = (bf16_t*)alloc((size_t)NL * 4 * 256 * 512 * 2); p.MV = (bf16_t*)alloc((size_t)NL * 4 * 256 * 512 * 2);
  p.MEMb = (bf16_t*)alloc((size_t)1024 * 1024 * 2); p.CCKVb = (bf16_t*)alloc((size_t)NL * 8 * 2048 * 256 * 2);
  p.ss = (float*)alloc((size_t)16 * R * 4); p.memss = (float*)alloc((size_t)16 * 1024 * 4);
  p.cqss = (float*)alloc((size_t)6 * R * 4); p.ckvss = (float*)alloc((size_t)4 * R * 4); p.KPE = (float*)alloc((size_t)R * 32 * 4);
  static int grid_blocks = 0;
  if (!grid_blocks) { int dev = 0, cus = 0, per_cu = 0; hipGetDevice(&dev); hipDeviceGetAttribute(&cus, hipDeviceAttributeMultiprocessorCount, dev);
    hipOccupancyMaxActiveBlocksPerMultiprocessor(&per_cu, mega, NTHR, 0); per_cu = 1; grid_blocks = cus * per_cu; }
  p.OB0 = (float*)alloc((size_t)R * 512 * 4);
  p.bar = (unsigned*)alloc((size_t)(XCD_BAR_WORDS + 4 * NAJ + 64) * 4); p.bflag = p.bar + XCD_BAR_WORDS; p.actr = p.bflag + 4 * NAJ;
  if (wo > ws_size) { fprintf(stderr, "workspace too small: need %zu have %zu\n", wo, ws_size); return; }
  for (int l = 0; l < 4; ++l) p.lam_init[l] = (float)(0.8 - 0.6 * exp(-0.3 * (double)l));
  (void)hipMemsetAsync(p.bar, 0, (size_t)(XCD_BAR_WORDS + 4 * NAJ + 64) * 4, stream);
#if MK_MULTI
  for (int ph = 0; ph < NPH; ++ph) { hipLaunchKernelGGL(mega, dim3(grid_blocks), dim3(NTHR), 0, stream, p, ph, ph + 1); }
#else
  int lo = 0, hi = NPH; void* args[] = {&p, &lo, &hi};
  hipError_t e = hipLaunchCooperativeKernel((void*)mega, dim3(grid_blocks), dim3(NTHR), args, 0, stream);
  if (e != hipSuccess) fprintf(stderr, "cooperative launch failed: %s (grid %d)\n", hipGetErrorString(e), grid_blocks);
#endif
}
```

```cpp
#include <hip/hip_runtime.h>
#include <hip/hip_cooperative_groups.h>
#include <cstdint>
#include <cstring>
#include <cstdio>
#include <cmath>
namespace cg = cooperative_groups;
#ifndef REP_UP
#define REP_UP 0
#endif
#ifndef REP_SYNC
#define REP_SYNC 0
#endif
#ifndef REP_ATT
#define REP_ATT 0
#endif

typedef unsigned short bf16_t;
typedef short bf16x8 __attribute__((ext_vector_type(8)));
typedef short s16x4 __attribute__((ext_vector_type(4)));
typedef float f32x16 __attribute__((ext_vector_type(16)));
typedef float f32x4 __attribute__((ext_vector_type(4)));
typedef unsigned u32x4 __attribute__((ext_vector_type(4)));
typedef unsigned u32x2 __attribute__((ext_vector_type(2)));

#define DI __device__ __forceinline__
#define MFMA32(a, b, c) __builtin_amdgcn_mfma_f32_32x32x16_bf16((a), (b), (c), 0, 0, 0)

constexpr int R = 16896, RP = 16384, DM = 1024, DFF = 2816, NL = 4;
constexpr int LDS_BYTES = 128 * 272 * 4;
constexpr int NTHR = 512;
constexpr int NAJ = 288;
constexpr float LOG2E = 1.4426950408889634f;
constexpr float EPS = 1e-6f;
constexpr int NPH = 2 + 10 * NL;
#ifndef MK_MINW
#define MK_MINW 2
#endif

DI unsigned pk2(float lo, float hi) { unsigned r; asm("v_cvt_pk_bf16_f32 %0, %1, %2" : "=v"(r) : "v"(lo), "v"(hi)); return r; }
DI float b2f(bf16_t b) { return __uint_as_float((unsigned)b << 16); }
DI int crow(int r, int hi) { return (r & 3) + 8 * (r >> 2) + 4 * hi; }
DI int ltid() { int t = threadIdx.x; asm volatile("" : "+v"(t)); return t; }


#define XB_TMO      128
#define XB_XCNT(j)  (256  + 64 * (j))
#define XB_XSUB(j)  (1280 + 64 * (j))
#define XB_XGEN(j)  (2304 + 64 * (j))
#define XB_TOP      3328
#define XB_TOPGEN   3392
#define XCD_BAR_WORDS 3456
#define XB_SPIN_CAP (1u << 18)
#define LAS __attribute__((address_space(3)))
DI unsigned xb_ld(unsigned* p)              { return __hip_atomic_load(p, __ATOMIC_RELAXED, __HIP_MEMORY_SCOPE_AGENT); }
DI unsigned xb_add(unsigned* p, unsigned v) { return __hip_atomic_fetch_add(p, v, __ATOMIC_RELAXED, __HIP_MEMORY_SCOPE_AGENT); }
DI unsigned xb_xcc_id() { return (unsigned)__builtin_amdgcn_s_getreg((3 << 11) | 20) & 0xFu; }
#define XB_SPIN(cond, bar) do { unsigned _sp = 0; while (cond) { __builtin_amdgcn_s_sleep(1); \
    if ((++_sp & 255u) == 0u) { if (xb_ld(&(bar)[XB_TMO])) break; if (_sp > XB_SPIN_CAP) { atomicAdd(&(bar)[XB_TMO], 1u); break; } } } } while (0)
struct XcdBarrier { unsigned* bar; unsigned x; volatile LAS unsigned* st; };
DI XcdBarrier xcd_barrier_post(unsigned* bar, volatile LAS unsigned* st) {
  XcdBarrier b; b.bar = bar; b.x = xb_xcc_id(); b.st = st;
  if (threadIdx.x == 0) (void)xb_add(&bar[XB_XCNT(b.x)], 1u);
  return b; }
DI void xcd_barrier_complete(unsigned* bar, unsigned x, unsigned& nloc, unsigned& nx) {
  const unsigned G = gridDim.x * gridDim.y * gridDim.z;
  unsigned sum, cnt, mine, sp = 0u;
  for (;;) {
    sum = 0u; cnt = 0u; mine = 0u;
#pragma unroll
    for (unsigned j = 0; j < 16; ++j) { const unsigned c = xb_ld(&bar[XB_XCNT(j)]); sum += c; cnt += (c > 0u) ? 1u : 0u; mine = (j == x) ? c : mine; }
    if (sum == G) break;
    __builtin_amdgcn_s_sleep(1);
    if ((++sp & 255u) == 0u) { if (xb_ld(&bar[XB_TMO])) break; if (sp > XB_SPIN_CAP) { atomicAdd(&bar[XB_TMO], 1u); break; } }
  }
  nloc = mine > 0u ? mine : 1u; nx = cnt > 0u ? cnt : 1u; }
DI void xcd_barrier(const XcdBarrier& b) {
  asm volatile("s_waitcnt vmcnt(0)" ::: "memory");
  __syncthreads();
  if (threadIdx.x == 0) {
    unsigned* bar = b.bar;
    __builtin_amdgcn_s_waitcnt(0);
    unsigned nloc = b.st[0], nx = b.st[1];
    if (nloc == 0u) { xcd_barrier_complete(bar, b.x, nloc, nx); b.st[0] = nloc; b.st[1] = nx; }
    const unsigned old = xb_add(&bar[XB_XSUB(b.x)], 1u);
    const unsigned gen = old / nloc;
    if (old + 1u == (gen + 1u) * nloc) {
      __builtin_amdgcn_fence(__ATOMIC_RELEASE, "agent");
      asm volatile("s_waitcnt vmcnt(0)" ::: "memory");
      const unsigned og = xb_add(&bar[XB_TOP], 1u);
      const unsigned tg = og / nx;
      if (og + 1u == (tg + 1u) * nx) xb_add(&bar[XB_TOPGEN], 1u);
      else XB_SPIN(xb_ld(&bar[XB_TOPGEN]) == tg, bar);
      __builtin_amdgcn_fence(__ATOMIC_ACQUIRE, "agent");
      xb_add(&bar[XB_XGEN(b.x)], 1u);
      asm volatile("s_waitcnt vmcnt(0)" ::: "memory");
    } else {
      XB_SPIN(xb_ld(&bar[XB_XGEN(b.x)]) == gen, bar);
      __builtin_amdgcn_fence(__ATOMIC_ACQUIRE, "agent");
      asm volatile("s_waitcnt vmcnt(0)" ::: "memory");
    }
  }
  __syncthreads();
}

struct Params {
  const float* in[43];
  float* out;
  long o_ys, o_pak, o_pav, o_pbk, o_pbv, o_pckv, o_pckpe, o_pmk, o_pmv, o_sak, o_sav, o_sbk, o_sbv, o_sckv, o_sckpe;
  bf16_t *Wgu1, *Wd1, *Win, *Wuq, *Wukv, *Wukvu, *Wout, *Wmq, *Wmkv, *Wmo, *Wgu2, *Wd2;
  bf16_t *Xb, *H, *OMIX, *OM, *QA, *QB, *QC, *QM, *CQraw, *CKVraw;
  bf16_t *PKA, *PVA, *PKB, *PVB, *PKC, *PVC;
  bf16_t *SKA, *SVA, *SKB, *SVB, *SKC, *SVC, *SKM, *SVM;
  bf16_t *MK, *MV, *MEMb, *CCKVb;
  float *ss, *memss, *cqss, *ckvss, *KPE, *OB0;
  unsigned* bar; unsigned* bflag; unsigned* actr;
  float lam_init[4];
};

DI float sumsq64(const float (&v)[64]) { float s = 0.f;
#pragma unroll
  for (int i = 0; i < 64; ++i) s += v[i] * v[i];
  return s; }
DI void store_bf16_64(bf16_t* dst, const float (&v)[64]) {
#pragma unroll
  for (int c = 0; c < 8; ++c) { u32x4 w; w.x = pk2(v[8 * c], v[8 * c + 1]); w.y = pk2(v[8 * c + 2], v[8 * c + 3]); w.z = pk2(v[8 * c + 4], v[8 * c + 5]); w.w = pk2(v[8 * c + 6], v[8 * c + 7]); *(u32x4*)(dst + 8 * c) = w; } }
DI void store_bf16_32(bf16_t* dst, const float (&v)[64]) {
#pragma unroll
  for (int c = 0; c < 4; ++c) { u32x4 w; w.x = pk2(v[8 * c], v[8 * c + 1]); w.y = pk2(v[8 * c + 2], v[8 * c + 3]); w.z = pk2(v[8 * c + 4], v[8 * c + 5]); w.w = pk2(v[8 * c + 6], v[8 * c + 7]); *(u32x4*)(dst + 8 * c) = w; } }
DI void store_f32_64(float* dst, const float (&v)[64]) {
#pragma unroll
  for (int c = 0; c < 16; ++c) { f32x4 w = {v[4 * c], v[4 * c + 1], v[4 * c + 2], v[4 * c + 3]}; *(f32x4*)(dst + 4 * c) = w; } }
DI void mulgain64(float (&v)[64], const float* g, float sc) {
#pragma unroll
  for (int c = 0; c < 16; ++c) { f32x4 w = *(const f32x4*)(g + 4 * c); v[4 * c] *= w.x * sc; v[4 * c + 1] *= w.y * sc; v[4 * c + 2] *= w.z * sc; v[4 * c + 3] *= w.w * sc; } }
DI void scale64(float (&v)[64], float sc) {
#pragma unroll
  for (int i = 0; i < 64; ++i) v[i] *= sc; }
DI float rstd_from(const float* ssp, int np, int stride, int row, float invn) { float s = 0.f; for (int q = 0; q < np; ++q) s += ssp[(size_t)q * stride + row]; return rsqrtf(s * invn + EPS); }
DI void rope32(float (&v)[64], int pos) {
  const float fp = (float)pos;
#pragma unroll
  for (int i = 0; i < 16; ++i) {
    const float inv = ((i & 3) == 0 ? 1.f : (i & 3) == 1 ? 0.5623413251903491f : (i & 3) == 2 ? 0.31622776601683794f : 0.17782794100389228f)
                    * ((i >> 2) == 0 ? 1.f : (i >> 2) == 1 ? 0.1f : (i >> 2) == 2 ? 0.01f : 0.001f);
    const float ang = fp * inv;
    float rev = ang * 0.15915494309189535f; rev -= floorf(rev);
    const float c = __builtin_amdgcn_cosf(rev), s = __builtin_amdgcn_sinf(rev);
    const float x1 = v[i], x2 = v[16 + i]; v[i] = x1 * c - x2 * s; v[16 + i] = x1 * s + x2 * c; } }

typedef int i32x4 __attribute__((ext_vector_type(4)));
DI int lds_byte2(int r, int c) { const int st = (r >> 4) * 2 + (c >> 5), ob = (r & 15) * 64 + (c & 31) * 2; return st * 1024 + (ob ^ (((ob >> 9) & 1) << 5)); }
DI void stage_rc2(int b, int& Rr, int& Cc) { const int st = b >> 10, sb = b & 1023, swz = sb ^ (((sb >> 9) & 1) << 5); Rr = (st >> 1) * 16 + swz / 64; Cc = (st & 1) * 32 + (swz % 64) / 2; }
constexpr int G_TILE_B = 256 * 64 * 2, G_STAGE_B = 2 * G_TILE_B;

template <int MT, class Epi>
DI void gemm_unit(char* smem, const bf16_t* __restrict__ A, int lda, const bf16_t* __restrict__ Bt, int ldb, int K, int row0, int col0, Epi epi) {
  const int tid = ltid(), wid = tid >> 6, lane = tid & 63, wr = wid >> 2, wc = wid & 3, fr = lane & 15, fq = lane >> 4;
  constexpr int GLA = MT / 2, GLB = 4;
  const bf16_t* Ab = A + (size_t)row0 * lda;
  const bf16_t* Bb = Bt + (size_t)col0 * ldb;
  int aoff[GLA], boff[GLB];
#pragma unroll
  for (int i = 0; i < GLA; ++i) { int rr, cc; stage_rc2(wid * 1024 + i * 8192 + lane * 16, rr, cc); aoff[i] = rr * lda + cc; }
#pragma unroll
  for (int i = 0; i < GLB; ++i) { int rr, cc; stage_rc2(wid * 1024 + i * 8192 + lane * 16, rr, cc); boff[i] = rr * ldb + cc; }
  f32x4 acc[MT][4];
#pragma unroll
  for (int m = 0; m < MT; ++m)
#pragma unroll
    for (int n = 0; n < 4; ++n) acc[m][n] = (f32x4){0.f, 0.f, 0.f, 0.f};
  i32x4 sa[GLA], sb[GLB];
#define U_SA(b) (smem + (b) * G_STAGE_B)
#define U_SB(b) (smem + (b) * G_STAGE_B + G_TILE_B)
#define U_ISSUE(kt) do { _Pragma("unroll") for (int i = 0; i < GLA; ++i) sa[i] = *(const i32x4*)(Ab + aoff[i] + (kt) * 64); \
    _Pragma("unroll") for (int i = 0; i < GLB; ++i) sb[i] = *(const i32x4*)(Bb + boff[i] + (kt) * 64); __builtin_amdgcn_sched_barrier(0); } while (0)
#define U_WRITE(buf) do { _Pragma("unroll") for (int i = 0; i < GLA; ++i) *(i32x4*)(U_SA(buf) + wid * 1024 + i * 8192 + lane * 16) = sa[i]; \
    _Pragma("unroll") for (int i = 0; i < GLB; ++i) *(i32x4*)(U_SB(buf) + wid * 1024 + i * 8192 + lane * 16) = sb[i]; } while (0)
#define U_RDA(m, buf, ks) (*(const bf16x8*)(U_SA(buf) + lds_byte2(wr * 16 * MT + (m) * 16 + fr, (ks) * 32 + fq * 8)))
#define U_MM(m, AR, BF) do { _Pragma("unroll") for (int n = 0; n < 4; ++n) acc[m][n] = __builtin_amdgcn_mfma_f32_16x16x32_bf16(BF[n], AR, acc[m][n], 0, 0, 0); } while (0)
#define U_SBAR __builtin_amdgcn_sched_barrier(0)
#define U_RDB(BF, buf, ks) do { _Pragma("unroll") for (int n = 0; n < 4; ++n) BF[n] = *(const bf16x8*)(U_SB(buf) + lds_byte2(wc * 64 + n * 16 + fr, (ks) * 32 + fq * 8)); } while (0)
#define U_KTILE(buf) do { bf16x8 Bf[4], Bg[4], A0, A1; \
    U_RDB(Bf, buf, 0); A0 = U_RDA(0, buf, 0); \
    _Pragma("unroll") for (int m = 0; m < MT; m += 2) { \
      A1 = U_RDA(m + 1, buf, 0); U_SBAR; U_MM(m, A0, Bf); U_SBAR; \
      if (m + 2 < MT) { A0 = U_RDA(m + 2, buf, 0); } else { U_RDB(Bg, buf, 1); A0 = U_RDA(0, buf, 1); } U_SBAR; U_MM(m + 1, A1, Bf); U_SBAR; } \
    _Pragma("unroll") for (int m = 0; m < MT; m += 2) { \
      A1 = U_RDA(m + 1, buf, 1); U_SBAR; U_MM(m, A0, Bg); U_SBAR; \
      if (m + 2 < MT) A0 = U_RDA(m + 2, buf, 1); U_SBAR; U_MM(m + 1, A1, Bg); U_SBAR; } } while (0)
  const int nt = K >> 6;
  float* rtab = (float*)(smem + 2 * G_STAGE_B);
  if constexpr (Epi::NEED_RSTD) { if (tid < 32 * MT) rtab[tid] = rstd_from(epi.ss, 16, R, row0 + tid, 1.f / 1024.f); }
  U_ISSUE(0); U_WRITE(0); U_ISSUE(1); __syncthreads();
#pragma unroll 1
  for (int t = 0; t < nt; ++t) { const int cur = t & 1;
    if (t + 1 < nt) U_WRITE(cur ^ 1);
    if (t + 2 < nt) U_ISSUE(t + 2);
    U_KTILE(cur);
    __syncthreads(); }
#undef U_SA
#undef U_SB
#undef U_ISSUE
#undef U_WRITE
#undef U_KTILE
#undef U_RDB
#undef U_RDA
#undef U_MM
#undef U_SBAR
  if constexpr (Epi::DIRECT) {
    epi.template direct<MT>(acc, row0, wr * 16 * MT, col0 + wc * 64, fr, fq, rtab);
    __syncthreads();
  } else {
    static_assert(MT <= 4, "LDS epilogue: the whole unit (<= 128 rows x 256 cols f32) is parked in LDS at once");
    float* Ct = (float*)smem;
#pragma unroll
    for (int m = 0; m < MT; ++m)
#pragma unroll
      for (int n = 0; n < 4; ++n) *(f32x4*)(Ct + (wr * 16 * MT + m * 16 + fr) * 272 + wc * 68 + n * 16 + fq * 4) = acc[m][n];
    __syncthreads();
    if (tid < 128 * MT) {
      const int row = tid >> 2, piece = tid & 3; float v[64];
      const float* src = Ct + row * 272 + piece * 68;
#pragma unroll
      for (int c = 0; c < 16; ++c) { const f32x4 t4 = *(const f32x4*)(src + 4 * c); v[4 * c] = t4.x; v[4 * c + 1] = t4.y; v[4 * c + 2] = t4.z; v[4 * c + 3] = t4.w; }
      epi.nt = (col0 >> 7) + (piece >> 1);
      epi(row0 + row, piece & 1, v);
    }
    __syncthreads();
  }
}

struct EpiFfnUp { const float* ss; bf16_t* H; int nt;
  static constexpr bool DIRECT = true, NEED_RSTD = true;
  template <int MT> DI void direct(const f32x4 (&acc)[MT][4], int row0, int lrow, int cbase, int fr, int fq, const float* rtab) const {
#pragma unroll
    for (int m = 0; m < MT; ++m) { const float rs = rtab[lrow + m * 16 + fr]; bf16_t* dst = H + (size_t)(row0 + lrow + m * 16 + fr) * DFF + (cbase >> 1) + fq * 4;
#pragma unroll
      for (int q = 0; q < 2; ++q) { float h[4];
#pragma unroll
        for (int j = 0; j < 4; ++j) { const float g = acc[m][2 * q][j] * rs, u = acc[m][2 * q + 1][j] * rs; h[j] = g * __builtin_amdgcn_rcpf(1.f + __expf(-g)) * u; }
        u32x2 w; w.x = pk2(h[0], h[1]); w.y = pk2(h[2], h[3]); *(u32x2*)(dst + q * 16) = w; } }
  }
  DI void operator()(int, int, float (&)[64]) const {} };

struct EpiResid { float* X; bf16_t* Xb; float* ss; int nt; float scale;
  static constexpr bool DIRECT = true, NEED_RSTD = false;
  template <int MT> DI void direct(const f32x4 (&acc)[MT][4], int row0, int lrow, int cbase, int fr, int fq, const float*) const {
#pragma unroll
    for (int m = 0; m < MT; ++m) { const int row = row0 + lrow + m * 16 + fr; float sq = 0.f;
      float* xp = X + (size_t)row * DM + cbase + fq * 4; bf16_t* bp = Xb + (size_t)row * DM + cbase + fq * 4;
#pragma unroll
      for (int n = 0; n < 4; ++n) { f32x4 x = *(const f32x4*)(xp + n * 16);
        x.x += scale * acc[m][n][0]; x.y += scale * acc[m][n][1]; x.z += scale * acc[m][n][2]; x.w += scale * acc[m][n][3];
        *(f32x4*)(xp + n * 16) = x; u32x2 w; w.x = pk2(x.x, x.y); w.y = pk2(x.z, x.w); *(u32x2*)(bp + n * 16) = w;
        sq += x.x * x.x + x.y * x.y + x.z * x.z + x.w * x.w; }
      sq += __shfl_xor(sq, 16); sq += __shfl_xor(sq, 32);
      if (fq == 0) ss[(size_t)(cbase >> 6) * R + row] = sq;
      if (m & 1) __builtin_amdgcn_sched_barrier(0); }
  }
  DI void operator()(int, int, float (&)[64]) const {} };

struct EpiProj { const Params* pp; int l; int nt;
  static constexpr bool DIRECT = false, NEED_RSTD = false;
  DI void operator()(int row, int half, float (&v)[64]) const {
    const Params& p = *pp;
    const bool samp = row >= RP; const int sr = row - RP; const int b = samp ? (sr >> 6) : (row >> 12); const int t = samp ? (sr & 63) : (row & 4095);
    scale64(v, rstd_from(p.ss, 16, R, row, 1.f / 1024.f));
    if (nt < 2) { const int head = 2 * nt + half; const float r2 = rsqrtf(sumsq64(v) * (1.f / 64.f) + EPS);
      mulgain64(v, p.in[17] + l * 64, r2 * 0.125f * LOG2E); store_bf16_64(p.QA + (size_t)row * 256 + head * 64, v);
    } else if (nt < 6) { const bool isk = nt < 4; const int head = 2 * (nt - (isk ? 2 : 4)) + half;
      if (isk) { const float r2 = rsqrtf(sumsq64(v) * (1.f / 64.f) + EPS); mulgain64(v, p.in[18] + l * 64, r2); }
      bf16_t* kb = isk ? (samp ? p.SKA : p.PKA) : (samp ? p.SVA : p.PVA);
      const size_t krow = samp ? ((size_t)(l * 8 + b) * 576 + 512 + t) : (size_t)row;
      store_bf16_64(kb + krow * 256 + head * 64, v);
      if (samp) store_f32_64(p.out + (isk ? p.o_sak : p.o_sav) + ((size_t)(l * 8 + b) * 64 + t) * 256 + head * 64, v);
      else if (t >= 3584) store_f32_64(p.out + (isk ? p.o_pak : p.o_pav) + ((size_t)(l * 4 + b) * 512 + (t - 3584)) * 256 + head * 64, v);
    } else if (nt < 10) { const int g = 2 * (nt - 6) + half; const float r2 = rsqrtf(sumsq64(v) * (1.f / 64.f) + EPS);
      mulgain64(v, p.in[20] + l * 64, r2 * 0.125f * LOG2E); store_bf16_64(p.QB + (size_t)row * 512 + g * 64, v);
    } else if (nt < 18) { const bool isk = nt < 14; const int col = isk ? (128 * (nt - 10) + 64 * half) : (128 * (nt - 14) + 64 * half);
      if (isk) { const float r2 = rsqrtf(sumsq64(v) * (1.f / 64.f) + EPS); mulgain64(v, p.in[21] + l * 64, r2); }
      bf16_t* kb = isk ? (samp ? p.SKB : p.PKB) : (samp ? p.SVB : p.PVB);
      const size_t krow = samp ? ((size_t)(l * 8 + b) * 2112 + 2048 + t) : (size_t)row;
      store_bf16_64(kb + krow * 512 + col, v);
      if (samp) store_f32_64(p.out + (isk ? p.o_sbk : p.o_sbv) + ((size_t)l * 512 + sr) * 512 + col, v);
      else store_f32_64(p.out + (isk ? p.o_pbk : p.o_pbv) + ((size_t)l * RP + row) * 512 + col, v);
    } else if (nt < 21) { const int col = 128 * (nt - 18) + 64 * half;
      store_bf16_64(p.CQraw + (size_t)row * 384 + col, v); p.cqss[(size_t)(2 * (nt - 18) + half) * R + row] = sumsq64(v);
    } else if (nt < 23) { const int col = 128 * (nt - 21) + 64 * half;
      store_bf16_64(p.CKVraw + (size_t)row * 256 + col, v); p.ckvss[(size_t)(2 * (nt - 21) + half) * R + row] = sumsq64(v);
      if (samp) store_f32_64(p.out + p.o_sckv + ((size_t)l * 512 + sr) * 256 + col, v);
      else store_f32_64(p.out + p.o_pckv + ((size_t)l * RP + row) * 256 + col, v);
    } else { if (half == 0) { rope32(v, samp ? 2048 + t : t);
        float* o = samp ? (p.out + p.o_sckpe + ((size_t)l * 512 + sr) * 32) : (p.out + p.o_pckpe + ((size_t)l * RP + row) * 32);
        float* kp = p.KPE + (size_t)row * 32;
#pragma unroll
        for (int c = 0; c < 8; ++c) { f32x4 w = {v[4 * c], v[4 * c + 1], v[4 * c + 2], v[4 * c + 3]}; *(f32x4*)(o + 4 * c) = w; *(f32x4*)(kp + 4 * c) = w; } } }
  } };

struct EpiQc { const Params* pp; int l; int nt;
  static constexpr bool DIRECT = false, NEED_RSTD = false;
  DI void operator()(int row, int half, float (&v)[64]) const {
    const Params& p = *pp; const int h = nt;
    const bool samp = row >= RP; const int sr = row - RP; const int t = samp ? (sr & 63) : (row & 4095);
    scale64(v, rstd_from(p.cqss, 6, R, row, 1.f / 384.f));
    float s;
    if (half) { rope32(v, samp ? 2048 + t : t); s = 0.f;
#pragma unroll
      for (int i = 0; i < 32; ++i) s += v[i] * v[i]; } else s = sumsq64(v);
    s += __shfl_xor(s, 1);
    const float r2 = rsqrtf(s * (1.f / 96.f) + EPS) * (0.10206207261596575f * LOG2E);
    const float* g = p.in[28] + l * 96 + half * 64; bf16_t* dst = p.QC + (size_t)row * 384 + h * 96 + half * 64;
    if (half == 0) { mulgain64(v, g, r2); store_bf16_64(dst, v); }
    else {
#pragma unroll
      for (int i = 0; i < 32; ++i) v[i] *= g[i] * r2;
      store_bf16_32(dst, v); }
  } };

struct EpiKv { const Params* pp; int l; int nt; int mode;
  static constexpr bool DIRECT = false, NEED_RSTD = false;
  DI void operator()(int row, int half, float (&v)[64]) const {
    const Params& p = *pp; const int h = nt;
    size_t krow; const float* kpe; float rs = 1.f;
    if (mode == 0) { const bool samp = row >= RP; const int sr = row - RP;
      krow = samp ? ((size_t)(l * 8 + (sr >> 6)) * 2112 + 2048 + (sr & 63)) : (size_t)row; kpe = p.KPE + (size_t)row * 32;
      rs = rstd_from(p.ckvss, 4, R, row, 1.f / 256.f);
      if (h == 0) {
        float* o = samp ? (p.out + p.o_sckv + ((size_t)l * 512 + sr) * 256) : (p.out + p.o_pckv + ((size_t)l * RP + row) * 256);
        const float* g = p.in[25] + l * 256;
        for (int c = 0; c < 32; ++c) { const int cc = half * 128 + 4 * c; f32x4 x = *(const f32x4*)(o + cc); const f32x4 gg = *(const f32x4*)(g + cc);
          x.x *= rs * gg.x; x.y *= rs * gg.y; x.z *= rs * gg.z; x.w *= rs * gg.w; *(f32x4*)(o + cc) = x; } }
    } else { const int b = row >> 11, pos = row & 2047; krow = (size_t)(l * 8 + b) * 2112 + pos; kpe = p.in[8] + ((size_t)(l * 8 + b) * 2048 + pos) * 32; }
    const bool tosamp = (mode == 1) || (row >= RP);
    scale64(v, rs);
    if (half == 0) { float kp[32]; float s = sumsq64(v);
#pragma unroll
      for (int c = 0; c < 8; ++c) { const f32x4 w = *(const f32x4*)(kpe + 4 * c); kp[4 * c] = w.x; kp[4 * c + 1] = w.y; kp[4 * c + 2] = w.z; kp[4 * c + 3] = w.w; s += w.x * w.x + w.y * w.y + w.z * w.z + w.w * w.w; }
      const float r2 = rsqrtf(s * (1.f / 96.f) + EPS); const float* g = p.in[29] + l * 96;
      mulgain64(v, g, r2);
      bf16_t* dst = (tosamp ? p.SKC : p.PKC) + krow * 384 + h * 96; store_bf16_64(dst, v);
#pragma unroll
      for (int c = 0; c < 4; ++c) { u32x4 w; w.x = pk2(kp[8 * c] * g[64 + 8 * c] * r2, kp[8 * c + 1] * g[65 + 8 * c] * r2); w.y = pk2(kp[8 * c + 2] * g[66 + 8 * c] * r2, kp[8 * c + 3] * g[67 + 8 * c] * r2);
        w.z = pk2(kp[8 * c + 4] * g[68 + 8 * c] * r2, kp[8 * c + 5] * g[69 + 8 * c] * r2); w.w = pk2(kp[8 * c + 6] * g[70 + 8 * c] * r2, kp[8 * c + 7] * g[71 + 8 * c] * r2); *(u32x4*)(dst + 64 + 8 * c) = w; }
    } else { store_bf16_64((tosamp ? p.SVC : p.PVC) + krow * 256 + h * 64, v); }
  } };

struct EpiMemQ { const Params* pp; int l; int nt;
  static constexpr bool DIRECT = false, NEED_RSTD = false;
  DI void operator()(int row, int half, float (&v)[64]) const {
    const Params& p = *pp; const int h = nt;
    scale64(v, rstd_from(p.ss, 16, R, row, 1.f / 1024.f));
    float s = sumsq64(v); s += __shfl_xor(s, 1);
    const float r2 = rsqrtf(s * (1.f / 128.f) + EPS) * (0.08838834764831845f * LOG2E);
    mulgain64(v, p.in[33] + l * 128 + half * 64, r2);
    store_bf16_64(p.QM + (size_t)row * 512 + h * 128 + half * 64, v);
  } };

struct EpiMemKV { const Params* pp; int l; int nt;
  static constexpr bool DIRECT = false, NEED_RSTD = false;
  DI void operator()(int row, int half, float (&v)[64]) const {
    const Params& p = *pp;
    scale64(v, rstd_from(p.memss, 16, 1024, row, 1.f / 1024.f));
    const size_t idx = ((size_t)l * 1024 + row) * 512 + (nt & 3) * 128 + half * 64;
    if (nt < 4) { float s = sumsq64(v); s += __shfl_xor(s, 1); const float r2 = rsqrtf(s * (1.f / 128.f) + EPS);
      mulgain64(v, p.in[37] + l * 128 + half * 64, r2); store_f32_64(p.out + p.o_pmk + idx, v); store_bf16_64(p.MK + idx, v);
    } else { store_f32_64(p.out + p.o_pmv + idx, v); store_bf16_64(p.MV + idx, v); }
  } };

typedef __attribute__((address_space(3))) const char* lds_cptr;
typedef short v4i16_t __attribute__((ext_vector_type(4)));
DI s16x4 vtr(const char* p) { return __builtin_bit_cast(s16x4, __builtin_amdgcn_ds_read_tr16_b64_v4i16((__attribute__((address_space(3))) v4i16_t*)(p))); }

constexpr int ATT_VOFF = 17408, ATT_STAGE = 17408 + 16384, ATT_TAB = 2 * ATT_STAGE;

template <int DQK, int DV, int MODE, bool PF = true>
DI void attn_core(char* smem, const bf16_t* Qrow, const bf16_t* __restrict__ Kb, int ldk, const bf16_t* __restrict__ Vb, int ldv,
                  int T0, int T1, int wlo, int whi, bool active, int qpos, int kpos0, float slope, f32x16 (&o)[DV / 32]) {
  const int tid = ltid(), lane = tid & 63, r32 = lane & 31, hi = lane >> 5;
  constexpr int KSTR = DQK * 2 + 16, KCH = DQK / 8, VCH = DV / 8, NKI = (64 * KCH + NTHR - 1) / NTHR, NVI = (64 * VCH + NTHR - 1) / NTHR, KTOT = 64 * KCH, VTOT = 64 * VCH, NKS = DQK / 16, NDH = DV / 32;
  bf16x8 qr[NKS];
#pragma unroll
  for (int ks = 0; ks < NKS; ++ks) { if (active) qr[ks] = *(const bf16x8*)(Qrow + ks * 16 + hi * 8); else qr[ks] = (bf16x8){0, 0, 0, 0, 0, 0, 0, 0}; }
#pragma unroll
  for (int d = 0; d < NDH; ++d)
#pragma unroll
    for (int i = 0; i < 16; ++i) o[d][i] = 0.f;
  float mhat = 0.f, lsum = 0.f;
  u32x4 kr[NKI], vr[NVI];
  int koff[NKI], voff[NVI]; int klds[NKI], vlds[NVI];
#pragma unroll
  for (int i = 0; i < NKI; ++i) { const int idx = min(tid + NTHR * i, KTOT - 1), key = idx / KCH, ch = idx % KCH; koff[i] = key * ldk + ch * 8; klds[i] = key * KSTR + ch * 16; }
#pragma unroll
  for (int i = 0; i < NVI; ++i) { const int idx = min(tid + NTHR * i, VTOT - 1), key = idx / VCH, ch = idx % VCH; voff[i] = key * ldv + ch * 8; vlds[i] = ATT_VOFF + (ch >> 2) * 4096 + key * 64 + (ch & 3) * 16; }
  const float* tab = (const float*)(smem + ATT_TAB);
  if (PF) {
    if (T0 < T1) {
#pragma unroll
      for (int i = 0; i < NKI; ++i) kr[i] = *(const u32x4*)(Kb + (size_t)T0 * 64 * ldk + koff[i]);
#pragma unroll
      for (int i = 0; i < NVI; ++i) vr[i] = *(const u32x4*)(Vb + (size_t)T0 * 64 * ldv + voff[i]);
#pragma unroll
      for (int i = 0; i < NKI; ++i) *(u32x4*)(smem + klds[i]) = kr[i];
#pragma unroll
      for (int i = 0; i < NVI; ++i) *(u32x4*)(smem + vlds[i]) = vr[i];
      if (T0 + 1 < T1) {
#pragma unroll
        for (int i = 0; i < NKI; ++i) kr[i] = *(const u32x4*)(Kb + (size_t)(T0 + 1) * 64 * ldk + koff[i]);
#pragma unroll
        for (int i = 0; i < NVI; ++i) vr[i] = *(const u32x4*)(Vb + (size_t)(T0 + 1) * 64 * ldv + voff[i]);
      }
    }
    __syncthreads();
#pragma unroll 1
    for (int t = T0; t < T1; ++t) {
      const int cur = (t - T0) & 1;
      const char* sbuf = smem + cur * ATT_STAGE;
      if (t + 1 < T1) {
        char* nb = smem + (cur ^ 1) * ATT_STAGE;
#pragma unroll
        for (int i = 0; i < NKI; ++i) *(u32x4*)(nb + klds[i]) = kr[i];
#pragma unroll
        for (int i = 0; i < NVI; ++i) *(u32x4*)(nb + vlds[i]) = vr[i];
      }
      if (t + 2 < T1) {
#pragma unroll
        for (int i = 0; i < NKI; ++i) kr[i] = *(const u32x4*)(Kb + (size_t)(t + 2) * 64 * ldk + koff[i]);
#pragma unroll
        for (int i = 0; i < NVI; ++i) vr[i] = *(const u32x4*)(Vb + (size_t)(t + 2) * 64 * ldv + voff[i]);
      }
  if (active && t >= wlo && t < whi) {
        f32x16 s0, s1;
#pragma unroll
        for (int i = 0; i < 16; ++i) { s0[i] = 0.f; s1[i] = 0.f; }
        const char* kp = sbuf + r32 * KSTR + hi * 16;
#pragma unroll
        for (int ks = 0; ks < NKS; ++ks) {
          const bf16x8 k0 = *(const bf16x8*)(kp + ks * 32), k1 = *(const bf16x8*)(kp + 32 * KSTR + ks * 32);
          s0 = MFMA32(k0, qr[ks], s0); s1 = MFMA32(k1, qr[ks], s1); }
        __builtin_amdgcn_sched_barrier(0);
        if (MODE != 0) {
          const int dbase = qpos - (kpos0 + 64 * t + 4 * hi); const float fdb = (float)dbase;
#pragma unroll
          for (int i = 0; i < 16; ++i) { const int d0 = dbase - ((i & 3) + 8 * (i >> 2)), d1 = d0 - 32;
            if (MODE == 1) { const int i0 = min(max(d0, -128), 128) + 128, i1 = min(max(d1, -128), 128) + 128; s0[i] += tab[i0]; s1[i] += tab[i1]; }
            else { s0[i] -= slope * fabsf(fdb - (float)((i & 3) + 8 * (i >> 2))); s1[i] -= slope * fabsf(fdb - (float)(32 + (i & 3) + 8 * (i >> 2))); } }
        }
        float mx = fmaxf(s0[0], s1[0]);
#pragma unroll
        for (int i = 1; i < 16; ++i) mx = fmaxf(mx, fmaxf(s0[i], s1[i]));
        mx = fmaxf(mx, __shfl_xor(mx, 32));
        if (t == wlo) mhat = mx;
        else { const float g = mx - mhat;
          if (__any(g > 8.f)) { const float dl = fmaxf(g, 0.f); mhat += dl; const float f = __builtin_amdgcn_exp2f(-dl); lsum *= f;
#pragma unroll
            for (int i = 0; i < 16; ++i) { const float fr = __shfl(f, crow(i, hi));
#pragma unroll
              for (int d = 0; d < NDH; ++d) o[d][i] *= fr; } } }
        float ls = 0.f;
#pragma unroll
        for (int i = 0; i < 16; ++i) { s0[i] = __builtin_amdgcn_exp2f(s0[i] - mhat); s1[i] = __builtin_amdgcn_exp2f(s1[i] - mhat); ls += s0[i] + s1[i]; }
        lsum += ls;
        u32x4 pw[4];
#pragma unroll
        for (int c = 0; c < 4; ++c) { pw[0][c] = pk2(s0[2 * c], s0[2 * c + 1]); pw[1][c] = pk2(s0[8 + 2 * c], s0[9 + 2 * c]); pw[2][c] = pk2(s1[2 * c], s1[2 * c + 1]); pw[3][c] = pk2(s1[8 + 2 * c], s1[9 + 2 * c]); }
        __builtin_amdgcn_sched_barrier(0);
        const char* vp = sbuf + ATT_VOFF + ((lane >> 4) & 1) * 32 + (lane & 3) * 8 + (4 * hi + ((lane & 15) >> 2)) * 64;
#pragma unroll
        for (int s = 0; s < 4; ++s) {
          const bf16x8 pa = __builtin_bit_cast(bf16x8, pw[s]);
#pragma unroll
          for (int d = 0; d < NDH; ++d) {
            const s16x4 lo = vtr(vp + d * 4096 + s * 1024), hh = vtr(vp + d * 4096 + s * 1024 + 512);
            const bf16x8 vf = {lo[0], lo[1], lo[2], lo[3], hh[0], hh[1], hh[2], hh[3]};
            o[d] = MFMA32(pa, vf, o[d]); }
          __builtin_amdgcn_sched_barrier(0); }
      }
      __syncthreads();
    }
  } else {
#pragma unroll 1
    for (int t = T0; t < T1; ++t) {
#pragma unroll
      for (int i = 0; i < NKI; ++i) kr[i] = *(const u32x4*)(Kb + (size_t)t * 64 * ldk + koff[i]);
#pragma unroll
      for (int i = 0; i < NVI; ++i) vr[i] = *(const u32x4*)(Vb + (size_t)t * 64 * ldv + voff[i]);
      __syncthreads();
#pragma unroll
      for (int i = 0; i < NKI; ++i) *(u32x4*)(smem + klds[i]) = kr[i];
#pragma unroll
      for (int i = 0; i < NVI; ++i) *(u32x4*)(smem + vlds[i]) = vr[i];
      __syncthreads();
      const char* sbuf = smem;
  if (active && t >= wlo && t < whi) {
        f32x16 s0, s1;
#pragma unroll
        for (int i = 0; i < 16; ++i) { s0[i] = 0.f; s1[i] = 0.f; }
        const char* kp = sbuf + r32 * KSTR + hi * 16;
#pragma unroll
        for (int ks = 0; ks < NKS; ++ks) {
          const bf16x8 k0 = *(const bf16x8*)(kp + ks * 32), k1 = *(const bf16x8*)(kp + 32 * KSTR + ks * 32);
          s0 = MFMA32(k0, qr[ks], s0); s1 = MFMA32(k1, qr[ks], s1); }
        __builtin_amdgcn_sched_barrier(0);
        if (MODE != 0) {
          const int dbase = qpos - (kpos0 + 64 * t + 4 * hi); const float fdb = (float)dbase;
#pragma unroll
          for (int i = 0; i < 16; ++i) { const int d0 = dbase - ((i & 3) + 8 * (i >> 2)), d1 = d0 - 32;
            if (MODE == 1) { const int i0 = min(max(d0, -128), 128) + 128, i1 = min(max(d1, -128), 128) + 128; s0[i] += tab[i0]; s1[i] += tab[i1]; }
            else { s0[i] -= slope * fabsf(fdb - (float)((i & 3) + 8 * (i >> 2))); s1[i] -= slope * fabsf(fdb - (float)(32 + (i & 3) + 8 * (i >> 2))); } }
        }
        float mx = fmaxf(s0[0], s1[0]);
#pragma unroll
        for (int i = 1; i < 16; ++i) mx = fmaxf(mx, fmaxf(s0[i], s1[i]));
        mx = fmaxf(mx, __shfl_xor(mx, 32));
        if (t == wlo) mhat = mx;
        else { const float g = mx - mhat;
          if (__any(g > 8.f)) { const float dl = fmaxf(g, 0.f); mhat += dl; const float f = __builtin_amdgcn_exp2f(-dl); lsum *= f;
#pragma unroll
            for (int i = 0; i < 16; ++i) { const float fr = __shfl(f, crow(i, hi));
#pragma unroll
              for (int d = 0; d < NDH; ++d) o[d][i] *= fr; } } }
        float ls = 0.f;
#pragma unroll
        for (int i = 0; i < 16; ++i) { s0[i] = __builtin_amdgcn_exp2f(s0[i] - mhat); s1[i] = __builtin_amdgcn_exp2f(s1[i] - mhat); ls += s0[i] + s1[i]; }
        lsum += ls;
        u32x4 pw[4];
#pragma unroll
        for (int c = 0; c < 4; ++c) { pw[0][c] = pk2(s0[2 * c], s0[2 * c + 1]); pw[1][c] = pk2(s0[8 + 2 * c], s0[9 + 2 * c]); pw[2][c] = pk2(s1[2 * c], s1[2 * c + 1]); pw[3][c] = pk2(s1[8 + 2 * c], s1[9 + 2 * c]); }
        __builtin_amdgcn_sched_barrier(0);
        const char* vp = sbuf + ATT_VOFF + ((lane >> 4) & 1) * 32 + (lane & 3) * 8 + (4 * hi + ((lane & 15) >> 2)) * 64;
#pragma unroll
        for (int s = 0; s < 4; ++s) {
          const bf16x8 pa = __builtin_bit_cast(bf16x8, pw[s]);
#pragma unroll
          for (int d = 0; d < NDH; ++d) {
            const s16x4 lo = vtr(vp + d * 4096 + s * 1024), hh = vtr(vp + d * 4096 + s * 1024 + 512);
            const bf16x8 vf = {lo[0], lo[1], lo[2], lo[3], hh[0], hh[1], hh[2], hh[3]};
            o[d] = MFMA32(pa, vf, o[d]); }
          __builtin_amdgcn_sched_barrier(0); }
      }
    }
  }
  if (active) {
    lsum += __shfl_xor(lsum, 32);
    const float linv = 1.f / lsum;
#pragma unroll
    for (int i = 0; i < 16; ++i) { const float li = __shfl(linv, crow(i, hi));
#pragma unroll
      for (int d = 0; d < NDH; ++d) o[d][i] *= li; }
  }
}

template <int NDH>
DI void store_o(bf16_t* dst  , int ld, const f32x16 (&o)[NDH], int r32, int hi) {
#pragma unroll
  for (int i = 0; i < 16; ++i) { bf16_t* rp = dst + (size_t)crow(i, hi) * ld + r32;
#pragma unroll
    for (int d = 0; d < NDH; ++d) rp[32 * d] = (bf16_t)(pk2(o[d][i], 0.f) & 0xffffu); }
}

DI void attn_job(char* smem, const Params& p, int l, int kind, bool samp, int b, int h, int qt, int q) {
  const int tid = ltid(), lane = tid & 63, wid = tid >> 6, r32 = lane & 31, hi = lane >> 5, ch4 = wid >> 1;
  const int row0 = samp ? (RP + 64 * b) : (b * 4096 + 256 * qt);
  const int wrow = row0 + 32 * wid;
  const bool active = samp ? (wid < 2) : true;
  const int qpos = (samp ? 2048 : 256 * qt) + 32 * wid + r32;
  const int cq = 4 * qt + ch4;
  __syncthreads();
  if (kind == 0) {
    { float* tab = (float*)(smem + ATT_TAB); const float* src = p.in[19] + (size_t)(l * 4 + h) * 257; for (int i = tid; i < 257; i += NTHR) tab[i] = src[i] * LOG2E; }
    int T0, T1, wlo, whi, kpos0; const bf16_t *K, *V;
    if (samp) { T0 = 0; T1 = 9; wlo = 0; whi = 9; kpos0 = 1536; K = p.SKA + (size_t)(l * 8 + b) * 576 * 256 + h * 64; V = p.SVA + (size_t)(l * 8 + b) * 576 * 256 + h * 64; }
    else { T0 = max(0, 4 * qt - 8); T1 = 4 * qt + 4; wlo = max(0, cq - 8); whi = cq + 1; kpos0 = 0; K = p.PKA + (size_t)b * 4096 * 256 + h * 64; V = p.PVA + (size_t)b * 4096 * 256 + h * 64; }
    f32x16 o[2];
    attn_core<64, 64, 1>(smem, p.QA + (size_t)(wrow + r32) * 256 + h * 64, K, 256, V, 256, T0, T1, wlo, whi, active, qpos, kpos0, 0.f, o);
    if (active) store_o<2>(p.OMIX + (size_t)wrow * 1024 + h * 64, 1024, o, r32, hi);
  } else if (kind == 2) {
    const bf16_t *K, *V; int T1, whi;
    if (samp) { T1 = 33; whi = 33; K = p.SKC + (size_t)(l * 8 + b) * 2112 * 384 + h * 96; V = p.SVC + (size_t)(l * 8 + b) * 2112 * 256 + h * 64; }
    else { T1 = 4 * qt + 4; whi = cq + 1; K = p.PKC + (size_t)b * 4096 * 384 + h * 96; V = p.PVC + (size_t)b * 4096 * 256 + h * 64; }
    f32x16 o[2];
    attn_core<96, 64, 0>(smem, p.QC + (size_t)(wrow + r32) * 384 + h * 96, K, 384, V, 256, 0, T1, 0, whi, active, qpos, 0, 0.f, o);
    if (active) store_o<2>(p.OMIX + (size_t)wrow * 1024 + 768 + h * 64, 1024, o, r32, hi);
  } else {
    const bf16_t *K, *V; int T1, whi;
    if (samp) { T1 = 33; whi = 33; K = p.SKB + (size_t)(l * 8 + b) * 2112 * 512; V = p.SVB + (size_t)(l * 8 + b) * 2112 * 512 + h * 128; }
    else { T1 = 4 * qt + 4; whi = cq + 1; K = p.PKB + (size_t)b * 4096 * 512; V = p.PVB + (size_t)b * 4096 * 512 + h * 128; }
    const float slope = exp2f(-2.f * (float)(h + 1)) * LOG2E;
    const int jj = (kind == 3) ? 1 : 0;
    f32x16 o[4];
    attn_core<64, 128, 2>(smem, p.QB + (size_t)(wrow + r32) * 512 + (h * 2 + jj) * 64, K + (h * 2 + jj) * 64, 512, V, 512, 0, T1, 0, whi, active, qpos, 0, slope, o);
    float* ob = p.OB0 + (size_t)wrow * 512 + h * 128 + r32;
    unsigned* flag = p.bflag + l * NAJ + q;
    if (jj == 0) {
      if (active) {
#pragma unroll
        for (int i = 0; i < 16; ++i)
#pragma unroll
          for (int d = 0; d < 4; ++d) ob[(size_t)crow(i, hi) * 512 + 32 * d] = o[d][i];
      }
      asm volatile("s_waitcnt vmcnt(0)" ::: "memory");
      __syncthreads();
      if (tid == 0) { __builtin_amdgcn_fence(__ATOMIC_RELEASE, "agent"); asm volatile("s_waitcnt vmcnt(0)" ::: "memory");
        __hip_atomic_store(flag, 1u, __ATOMIC_RELAXED, __HIP_MEMORY_SCOPE_AGENT); }
    } else {
      float lam;
      { const float* bl = p.in[22] + (size_t)l * 256; float p1 = bl[lane] * bl[64 + lane], p2 = bl[128 + lane] * bl[192 + lane];
#pragma unroll
        for (int m = 1; m < 64; m <<= 1) { p1 += __shfl_xor(p1, m); p2 += __shfl_xor(p2, m); }
        lam = expf(p1) - expf(p2) + p.lam_init[l]; }
      if (tid == 0) { unsigned sp = 0u; while (__hip_atomic_load(flag, __ATOMIC_RELAXED, __HIP_MEMORY_SCOPE_AGENT) == 0u && ++sp < (1u << 20)) __builtin_amdgcn_s_sleep(2);
        __builtin_amdgcn_fence(__ATOMIC_ACQUIRE, "agent"); asm volatile("s_waitcnt vmcnt(0)" ::: "memory"); }
      __syncthreads();
      if (active) {
        const float* gsub = p.in[23] + l * 128; const float omz = 1.f - p.lam_init[l];
#pragma unroll
        for (int i = 0; i < 16; ++i)
#pragma unroll
          for (int d = 0; d < 4; ++d) o[d][i] = ob[(size_t)crow(i, hi) * 512 + 32 * d] - lam * o[d][i];
#pragma unroll
        for (int i = 0; i < 16; ++i) { float sq = o[0][i] * o[0][i] + o[1][i] * o[1][i] + o[2][i] * o[2][i] + o[3][i] * o[3][i];
          sq += __shfl_xor(sq, 1); sq += __shfl_xor(sq, 2); sq += __shfl_xor(sq, 4); sq += __shfl_xor(sq, 8); sq += __shfl_xor(sq, 16);
          const float r2 = rsqrtf(sq * (1.f / 128.f) + EPS) * omz;
#pragma unroll
          for (int d = 0; d < 4; ++d) o[d][i] *= r2 * gsub[32 * d + r32]; }
        store_o<4>(p.OMIX + (size_t)wrow * 1024 + 256 + h * 128, 1024, o, r32, hi);
      }
    }
  }
}

DI void mem_attn(char* smem, const Params& p, int l, int row0, int nrows, int h, const bf16_t* K, const bf16_t* V) {
  const int tid = ltid(), lane = tid & 63, wid = tid >> 6, r32 = lane & 31, hi = lane >> 5;
  const bool active = 32 * wid < nrows; const int wrow = row0 + 32 * wid;
  f32x16 o[4];
  __syncthreads();
  attn_core<128, 128, 0, false>(smem, p.QM + (size_t)(wrow + r32) * 512 + h * 128, K + h * 128, 512, V + h * 128, 512, 0, 4, 0, 4, active, 0, 0, 0.f, o);
  if (active) store_o<4>(p.OM + (size_t)wrow * 512 + h * 128, 512, o, r32, hi);
}

constexpr int WT_PER_LAYER = 352 * 2 + 176 * 2 + 192 + 12 + 8 + 8 + 64 + 32 + 64 + 32;
DI void wt_job(char* smem, const Params& p, int job) {
  const int l = job / WT_PER_LAYER; int r = job % WT_PER_LAYER;
  bf16_t* dst; int K, ntk, map; const float* gain = nullptr; const float* s0; const float* s1 = nullptr; int ldsrc;
  if (r < 352) { dst = p.Wgu1 + (size_t)l * 5632 * 1024; K = 1024; map = 1; gain = p.in[11] + l * 1024; s0 = p.in[12] + (size_t)l * 1024 * 2816; s1 = p.in[13] + (size_t)l * 1024 * 2816; ldsrc = 2816; }
  else if ((r -= 352) < 176) { dst = p.Wd1 + (size_t)l * 1024 * 2816; K = 2816; map = 0; s0 = p.in[14] + (size_t)l * 2816 * 1024; ldsrc = 1024; }
  else if ((r -= 176) < 192) { dst = p.Win + (size_t)l * 3072 * 1024; K = 1024; map = 0; gain = p.in[15] + l * 1024; s0 = p.in[16] + (size_t)l * 1024 * 2976; ldsrc = 2976; }
  else if ((r -= 192) < 12) { dst = p.Wuq + (size_t)l * 512 * 384; K = 384; map = 2; gain = p.in[24] + l * 384; s0 = p.in[26] + (size_t)l * 384 * 384; ldsrc = 384; }
  else if ((r -= 12) < 8) { dst = p.Wukv + (size_t)l * 512 * 256; K = 256; map = 0; gain = p.in[25] + l * 256; s0 = p.in[27] + (size_t)l * 256 * 512; ldsrc = 512; }
  else if ((r -= 8) < 8) { dst = p.Wukvu + (size_t)l * 512 * 256; K = 256; map = 0; s0 = p.in[27] + (size_t)l * 256 * 512; ldsrc = 512; }
  else if ((r -= 8) < 64) { dst = p.Wout + (size_t)l * 1024 * 1024; K = 1024; map = 0; s0 = p.in[30] + (size_t)l * 1024 * 1024; ldsrc = 1024; }
  else if ((r -= 64) < 32) { dst = p.Wmq + (size_t)l * 512 * 1024; K = 1024; map = 0; gain = p.in[31] + l * 1024; s0 = p.in[32] + (size_t)l * 1024 * 512; ldsrc = 512; }
  else if ((r -= 32) < 64) { dst = p.Wmkv + (size_t)l * 1024 * 1024; K = 1024; map = 3; gain = p.in[34] + l * 1024; s0 = p.in[35] + (size_t)l * 1024 * 512; s1 = p.in[36] + (size_t)l * 1024 * 512; ldsrc = 512; }
  else if ((r -= 64) < 32) { dst = p.Wmo + (size_t)l * 1024 * 512; K = 512; map = 0; s0 = p.in[38] + (size_t)l * 512 * 1024; ldsrc = 1024; }
  else if ((r -= 32) < 352) { dst = p.Wgu2 + (size_t)l * 5632 * 1024; K = 1024; map = 1; gain = p.in[39] + l * 1024; s0 = p.in[40] + (size_t)l * 1024 * 2816; s1 = p.in[41] + (size_t)l * 1024 * 2816; ldsrc = 2816; }
  else { r -= 352; dst = p.Wd2 + (size_t)l * 1024 * 2816; K = 2816; map = 0; s0 = p.in[42] + (size_t)l * 2816 * 1024; ldsrc = 1024; }
  ntk = K >> 6;
  const int n0 = (r / ntk) * 256, k0 = (r % ntk) * 64;
  const int tid = ltid();
  float* lf = (float*)smem;
  { const int c4 = tid & 63, kq = tid >> 6; const int np = n0 + 4 * c4; const float* src = s0; int col;
    if (map == 0) col = np < ldsrc ? np : -1;
    else if (map == 1) { const int w = np & 63, sub = w >> 4; col = (np >> 6) * 32 + (sub >> 1) * 16 + (w & 15); if (sub & 1) src = s1; }
    else if (map == 2) { col = (np & 127) < 96 ? (np >> 7) * 96 + (np & 127) : -1; }
    else { if (np < 512) col = np; else { col = np - 512; src = s1; } }
#pragma unroll
    for (int i = 0; i < 8; ++i) { const int kl = kq + 8 * i; f32x4 x = {0.f, 0.f, 0.f, 0.f};
      if (col >= 0) { x = *(const f32x4*)(src + (size_t)(k0 + kl) * ldsrc + col); if (gain) { const float g = gain[k0 + kl]; x.x *= g; x.y *= g; x.z *= g; x.w *= g; } }
      *(f32x4*)(lf + kl * 260 + 4 * c4) = x; } }
  __syncthreads();
  { const int nl = tid >> 1, kh = (tid & 1) * 32; float x[32];
#pragma unroll
    for (int j = 0; j < 32; ++j) x[j] = lf[(kh + j) * 260 + nl];
    bf16_t* d = dst + (size_t)(n0 + nl) * K + k0 + kh;
#pragma unroll
    for (int c = 0; c < 4; ++c) { u32x4 w = {pk2(x[8 * c], x[8 * c + 1]), pk2(x[8 * c + 2], x[8 * c + 3]), pk2(x[8 * c + 4], x[8 * c + 5]), pk2(x[8 * c + 6], x[8 * c + 7])}; *(u32x4*)(d + 8 * c) = w; } }
  __syncthreads();
}

DI void rowprep_job(const Params& p, int job, bool mem) {
  const int tid = ltid(), lane = tid & 63, wid = tid >> 6; const int row = 8 * job + wid;
  const float* src = mem ? (p.in[2] + (size_t)row * DM) : (row < RP ? p.in[0] + (size_t)row * DM : p.in[1] + (size_t)(row - RP) * DM);
  f32x4 x[4]; float s = 0.f;
#pragma unroll
  for (int c = 0; c < 4; ++c) { x[c] = *(const f32x4*)(src + lane * 16 + 4 * c); s += x[c].x * x[c].x + x[c].y * x[c].y + x[c].z * x[c].z + x[c].w * x[c].w; }
  if (!mem) {
#pragma unroll
    for (int c = 0; c < 4; ++c) *(f32x4*)(p.out + (size_t)row * DM + lane * 16 + 4 * c) = x[c]; }
  bf16_t* d = (mem ? p.MEMb : p.Xb) + (size_t)row * DM + lane * 16;
  u32x4 w0 = {pk2(x[0].x, x[0].y), pk2(x[0].z, x[0].w), pk2(x[1].x, x[1].y), pk2(x[1].z, x[1].w)}, w1 = {pk2(x[2].x, x[2].y), pk2(x[2].z, x[2].w), pk2(x[3].x, x[3].y), pk2(x[3].z, x[3].w)};
  *(u32x4*)d = w0; *(u32x4*)(d + 8) = w1;
  s += __shfl_xor(s, 1); s += __shfl_xor(s, 2);
  if ((lane & 3) == 0) { if (mem) p.memss[(size_t)(lane >> 2) * 1024 + row] = s; else p.ss[(size_t)(lane >> 2) * R + row] = s; }
}

DI void conv_job(const float* src, bf16_t* dst, int job, int chunk, int dstride) {
  const size_t e = (size_t)job * 4096 + ltid() * 8;
  const f32x4 a = *(const f32x4*)(src + e), b = *(const f32x4*)(src + e + 4);
  u32x4 w = {pk2(a.x, a.y), pk2(a.z, a.w), pk2(b.x, b.y), pk2(b.z, b.w)};
  const size_t q = e / (size_t)chunk, rm = e % (size_t)chunk;
  *(u32x4*)(dst + q * (size_t)dstride + rm) = w;
}


DI void gemm_decode(int j, int MT, int NT, int& m, int& n) {
  const int rowsz = 8 * NT, sm = j / rowsz, jr = j - sm * rowsz, rows = min(8, MT - 8 * sm), nfull = NT >> 3, blk = rows * 8;
  int sn, w, local;
  if (jr < nfull * blk) { sn = jr / blk; w = 8; local = jr - sn * blk; } else { sn = nfull; w = NT - 8 * nfull; local = jr - nfull * blk; }
  const int ni = local / rows; m = 8 * sm + (local - ni * rows); n = 8 * sn + ni; }
DI bool gemm_job(int it, int MT, int NT, int& m, int& n) {
  const int G = gridDim.x, bid = blockIdx.x, per = G >> 3;
  if (it >= (MT * NT) / G) return false;
  gemm_decode((it * 8 + (bid & 7)) * per + (bid >> 3), MT, NT, m, n); return true; }
DI bool gemm_tail(int it, int MT, int NT, int& m, int& n, int& half) {
  const int G = gridDim.x, t = blockIdx.x + it * G, tot = MT * NT, base = (tot / G) * G, L = tot - base;
  if (t >= 2 * L) return false;
  gemm_decode(base + (t >> 1), MT, NT, m, n); half = t & 1; return true; }

template <int SEL>
DI void run_phase(const Params& p, char* smem, int ph) {
  const int G = gridDim.x, bid = blockIdx.x;
#ifdef ONLY_S
  if (ph < 2 && ONLY_S < 10) return;
  if (ph >= 2 && ONLY_S >= 10) return;
#endif
  if (ph == 0) {
    constexpr int NWT = WT_PER_LAYER * NL;
    constexpr int J1 = NWT, J2 = J1 + R / 8, J3 = J2 + 128, J4 = J3 + 1024, J5 = J4 + 1024, J6 = J5 + 8192, J7 = J6 + 8192, J8 = J7 + 1024, J9 = J8 + 1024, J10 = J9 + 4096;
    for (int j = bid; j < J10; j += G) {
      if (j < J1) wt_job(smem, p, j);
      else if (j < J2) rowprep_job(p, j - J1, false);
      else if (j < J3) rowprep_job(p, j - J2, true);
      else if (j < J4) conv_job(p.in[3], p.SKA, j - J3, 512 * 256, 576 * 256);
      else if (j < J5) conv_job(p.in[4], p.SVA, j - J4, 512 * 256, 576 * 256);
      else if (j < J6) conv_job(p.in[5], p.SKB, j - J5, 2048 * 512, 2112 * 512);
      else if (j < J7) conv_job(p.in[6], p.SVB, j - J6, 2048 * 512, 2112 * 512);
      else if (j < J8) conv_job(p.in[9], p.SKM, j - J7, 256 * 512, 256 * 512);
      else if (j < J9) conv_job(p.in[10], p.SVM, j - J8, 256 * 512, 256 * 512);
      else conv_job(p.in[7], p.CCKVb, j - J9, 2048 * 256, 2048 * 256);
    }
    return;
  }
  if (ph == 1) {
    for (int j = bid; j < 128 + 1024; j += G) {
      if (j < 128) { const int l = j >> 5, m = (j >> 2) & 7, n = j & 3;
        gemm_unit<4>(smem, p.MEMb, 1024, p.Wmkv + (size_t)l * 1024 * 1024, 1024, 1024, m * 128, n * 256, EpiMemKV{&p, l, 0});
      } else { const int q = j - 128, l = q >> 8, m = (q >> 1) & 127, n = q & 1;
        gemm_unit<4>(smem, p.CCKVb + (size_t)l * 16384 * 256, 256, p.Wukvu + (size_t)l * 512 * 256, 256, 256, m * 128, n * 256, EpiKv{&p, l, 0, 1}); }
    }
    return;
  }
  const int l = (ph - 2) / 10, s = (ph - 2) % 10;
#ifdef ONLY_S
  if (s != ONLY_S) return;
#endif
  if (s == 0 || s == 8) {
    const bf16_t* W = p.Wgu1 + (size_t)((s == 0 ? 0 : NL) + l) * 5632 * 1024;
    for (int it = 0;; ++it) { int m, n; if (!gemm_job(it, 66, 22, m, n)) break;
      gemm_unit<8>(smem, p.Xb, 1024, W, 1024, 1024, m * 256, n * 256, EpiFfnUp{p.ss, p.H, 0}); }
    for (int it = 0;; ++it) { int m, n, hf; if (!gemm_tail(it, 66, 22, m, n, hf)) break;
      gemm_unit<4>(smem, p.Xb, 1024, W, 1024, 1024, m * 256 + 128 * hf, n * 256, EpiFfnUp{p.ss, p.H, 0}); }
  } else if (s == 1 || s == 9) {
    const bf16_t* W = p.Wd1 + (size_t)((s == 1 ? 0 : NL) + l) * 1024 * 2816;
    for (int j = bid; j < 256; j += G) gemm_unit<8>(smem, p.H, DFF, W, DFF, DFF, (j >> 2) * 256, (j & 3) * 256, EpiResid{p.out, p.Xb, p.ss, 0, 0.5f});
    for (int t = bid; t < 32; t += G) gemm_unit<2>(smem, p.H, DFF, W, DFF, DFF, RP + 64 * (t >> 2), (t & 3) * 256, EpiResid{p.out, p.Xb, p.ss, 0, 0.5f});
  } else if (s == 2) {
    const bf16_t* W = p.Win + (size_t)l * 3072 * 1024;
    for (int it = 0;; ++it) { int m, n; if (!gemm_job(it, 132, 12, m, n)) break;
      gemm_unit<4>(smem, p.Xb, 1024, W, 1024, 1024, m * 128, n * 256, EpiProj{&p, l, 0}); }
    for (int it = 0;; ++it) { int m, n, hf; if (!gemm_tail(it, 132, 12, m, n, hf)) break;
      gemm_unit<2>(smem, p.Xb, 1024, W, 1024, 1024, m * 128 + 64 * hf, n * 256, EpiProj{&p, l, 0}); }
  } else if (s == 3) {
    for (int j = bid; j < 132 * 4; j += G) { const int m = j >> 2, n = (j >> 1) & 1;
      if (j & 1) gemm_unit<4>(smem, p.CKVraw, 256, p.Wukv + (size_t)l * 512 * 256, 256, 256, m * 128, n * 256, EpiKv{&p, l, 0, 0});
      else gemm_unit<4>(smem, p.CQraw, 384, p.Wuq + (size_t)l * 512 * 384, 384, 384, m * 128, n * 256, EpiQc{&p, l, 0}); }
  } else if (s == 4) {
    constexpr int NJ = 4 * NAJ;
    int* sj = (int*)(smem + 72000);
    for (;;) {
      __syncthreads();
      if (threadIdx.x == 0) *sj = (int)__hip_atomic_fetch_add(p.actr + l, 1u, __ATOMIC_RELAXED, __HIP_MEMORY_SCOPE_AGENT);
      __syncthreads();
      const int j = *sj; if (j >= NJ) break;
      const int grp = j / NAJ, q = j % NAJ; const int kind = grp == 0 ? 1 : (grp == 1 ? 3 : (grp == 2 ? 2 : 0));
      const bool sm = q >= 256;
      attn_job(smem, p, l, kind, sm, sm ? ((q - 256) >> 2) : ((q >> 2) & 3), q & 3, sm ? 0 : 15 - (q >> 4), q); }
  } else if (s == 5) {
    const bf16_t* W = p.Wout + (size_t)l * 1024 * 1024;
    for (int j = bid; j < 256; j += G) gemm_unit<8>(smem, p.OMIX, 1024, W, 1024, 1024, (j >> 2) * 256, (j & 3) * 256, EpiResid{p.out, p.Xb, p.ss, 0, 1.0f});
    for (int t = bid; t < 32; t += G) gemm_unit<2>(smem, p.OMIX, 1024, W, 1024, 1024, RP + 64 * (t >> 2), (t & 3) * 256, EpiResid{p.out, p.Xb, p.ss, 0, 1.0f});
  } else if (s == 6) {
    const bf16_t* W = p.Wmq + (size_t)l * 512 * 1024;
    for (int j = bid; j < 128 + 16; j += G) {
      if (j < 128) { const int m = j >> 1, n = j & 1, b = m >> 4;
        gemm_unit<4>(smem, p.Xb, 1024, W, 1024, 1024, m * 256, n * 256, EpiMemQ{&p, l, 0});
        gemm_unit<4>(smem, p.Xb, 1024, W, 1024, 1024, m * 256 + 128, n * 256, EpiMemQ{&p, l, 0});
        __threadfence(); __syncthreads();
        for (int u = 0; u < 2; ++u) mem_attn(smem, p, l, m * 256, 256, 2 * n + u, p.MK + (size_t)(l * 4 + b) * 256 * 512, p.MV + (size_t)(l * 4 + b) * 256 * 512);
      } else { const int sb = (j - 128) >> 1, n = j & 1;
        gemm_unit<2>(smem, p.Xb, 1024, W, 1024, 1024, RP + 64 * sb, n * 256, EpiMemQ{&p, l, 0});
        __threadfence(); __syncthreads();
        for (int u = 0; u < 2; ++u) mem_attn(smem, p, l, RP + 64 * sb, 64, 2 * n + u, p.SKM + (size_t)(l * 8 + sb) * 256 * 512, p.SVM + (size_t)(l * 8 + sb) * 256 * 512); }
    }
  } else if (s == 7) {
    const bf16_t* W = p.Wmo + (size_t)l * 1024 * 512;
    for (int j = bid; j < 256; j += G) gemm_unit<8>(smem, p.OM, 512, W, 512, 512, (j >> 2) * 256, (j & 3) * 256, EpiResid{p.out, p.Xb, p.ss, 0, 1.0f});
    for (int t = bid; t < 32; t += G) gemm_unit<2>(smem, p.OM, 512, W, 512, 512, RP + 64 * (t >> 2), (t & 3) * 256, EpiResid{p.out, p.Xb, p.ss, 0, 1.0f});
  }
}

__global__ void __launch_bounds__(NTHR, 2) mega(Params p, int ph_lo, int ph_hi) {
  __shared__ __attribute__((aligned(16))) char smem[LDS_BYTES];
  __shared__ uint4 xb_words;
  if (ph_hi < 0) { cg::this_grid().sync(); }
  if (threadIdx.x == 0) xb_words = make_uint4(0u, 0u, 0u, 0u);
  __syncthreads();
  XcdBarrier xb = xcd_barrier_post(p.bar, (volatile LAS unsigned*)&xb_words);
  for (int ph = ph_lo; ph < ph_hi; ++ph) {
    run_phase<-1>(p, smem, ph);
#if REP_UP
    if (ph >= 2 && ((ph - 2) % 10 == 0 || (ph - 2) % 10 == 8)) { xcd_barrier(xb); run_phase<-1>(p, smem, ph); }
#endif
#if REP_ATT
    if (ph >= 2 && ((ph - 2) % 10 == 4)) { xcd_barrier(xb); run_phase<-1>(p, smem, ph); }
#endif
    if (ph + 1 < ph_hi) xcd_barrier(xb);
#if REP_SYNC
    if (ph + 1 < ph_hi) xcd_barrier(xb);
#endif
  }
}

#ifndef MK_MULTI
#define MK_MULTI 0
#endif

extern "C" void kernel_launch(void* const* d_in, const int* in_sizes, int n_in, void* d_out, int out_size, void* d_ws, size_t ws_size, hipStream_t stream) {
  Params p; memset(&p, 0, sizeof(p));
  for (int i = 0; i < 43; ++i) p.in[i] = (const float*)d_in[i];
  p.out = (float*)d_out;
  long off = 0;
  auto take = [&](long n) { long o = off; off += n; return o; };
  take((long)RP * DM); p.o_ys = take(512L * DM);
  p.o_pak = take(4L * 4 * 512 * 256); p.o_pav = take(4L * 4 * 512 * 256);
  p.o_pbk = take(4L * RP * 512); p.o_pbv = take(4L * RP * 512);
  p.o_pckv = take(4L * RP * 256); p.o_pckpe = take(4L * RP * 32);
  p.o_pmk = take(4L * 4 * 256 * 512); p.o_pmv = take(4L * 4 * 256 * 512);
  p.o_sak = take(4L * 512 * 256); p.o_sav = take(4L * 512 * 256);
  p.o_sbk = take(4L * 512 * 512); p.o_sbv = take(4L * 512 * 512);
  p.o_sckv = take(4L * 512 * 256); p.o_sckpe = take(4L * 512 * 32);
  char* ws = (char*)d_ws; size_t wo = 0;
  auto alloc = [&](size_t bytes) { char* r = ws + wo; wo += (bytes + 255) & ~(size_t)255; return r; };
  p.Wgu1 = (bf16_t*)alloc((size_t)2 * NL * 5632 * 1024 * 2); p.Wd1 = (bf16_t*)alloc((size_t)2 * NL * 1024 * 2816 * 2);
  p.Wgu2 = p.Wgu1 + (size_t)NL * 5632 * 1024; p.Wd2 = p.Wd1 + (size_t)NL * 1024 * 2816;
  p.Win = (bf16_t*)alloc((size_t)NL * 3072 * 1024 * 2); p.Wuq = (bf16_t*)alloc((size_t)NL * 512 * 384 * 2);
  p.Wukv = (bf16_t*)alloc((size_t)NL * 512 * 256 * 2); p.Wukvu = (bf16_t*)alloc((size_t)NL * 512 * 256 * 2);
  p.Wout = (bf16_t*)alloc((size_t)NL * 1024 * 1024 * 2); p.Wmq = (bf16_t*)alloc((size_t)NL * 512 * 1024 * 2);
  p.Wmkv = (bf16_t*)alloc((size_t)NL * 1024 * 1024 * 2); p.Wmo = (bf16_t*)alloc((size_t)NL * 1024 * 512 * 2);
  p.Xb = (bf16_t*)alloc((size_t)R * 1024 * 2);
  const size_t ubase = wo;
  p.OMIX = (bf16_t*)alloc((size_t)R * 1024 * 2); p.QA = (bf16_t*)alloc((size_t)R * 256 * 2); p.QB = (bf16_t*)alloc((size_t)R * 512 * 2);
  p.QC = (bf16_t*)alloc((size_t)R * 384 * 2); p.CQraw = (bf16_t*)alloc((size_t)R * 384 * 2); p.CKVraw = (bf16_t*)alloc((size_t)R * 256 * 2);
  p.PKA = (bf16_t*)alloc((size_t)RP * 256 * 2); p.PVA = (bf16_t*)alloc((size_t)RP * 256 * 2);
  p.PKB = (bf16_t*)alloc((size_t)RP * 512 * 2); p.PVB = (bf16_t*)alloc((size_t)RP * 512 * 2);
  p.PKC = (bf16_t*)alloc((size_t)RP * 384 * 2); p.PVC = (bf16_t*)alloc((size_t)RP * 256 * 2);
  p.H = (bf16_t*)(ws + ubase);
  if (wo - ubase < (size_t)R * DFF * 2) wo = ubase + (size_t)R * DFF * 2;
  p.OM = (bf16_t*)alloc((size_t)R * 512 * 2); p.QM = (bf16_t*)alloc((size_t)R * 512 * 2);
  p.SKA = (bf16_t*)alloc((size_t)NL * 8 * 576 * 256 * 2); p.SVA = (bf16_t*)alloc((size_t)NL * 8 * 576 * 256 * 2);
  p.SKB = (bf16_t*)alloc((size_t)NL * 8 * 2112 * 512 * 2); p.SVB = (bf16_t*)alloc((size_t)NL * 8 * 2112 * 512 * 2);
  p.SKC = (bf16_t*)alloc((size_t)NL * 8 * 2112 * 384 * 2); p.SVC = (bf16_t*)alloc((size_t)NL * 8 * 2112 * 256 * 2);
  p.SKM = (bf16_t*)alloc((size_t)NL * 8 * 256 * 512 * 2); p.SVM = (bf16_t*)alloc((size_t)NL * 8 * 256 * 512 * 2);
  p.MK = (bf16_t*)alloc((size_t)NL * 4 * 256 * 512 * 2); p.MV = (bf16_t*)alloc((size_t)NL * 4 * 256 * 512 * 2);
  p.MEMb = (bf16_t*)alloc((size_t)1024 * 1024 * 2); p.CCKVb = (bf16_t*)alloc((size_t)NL * 8 * 2048 * 256 * 2);
  p.ss = (float*)alloc((size_t)16 * R * 4); p.memss = (float*)alloc((size_t)16 * 1024 * 4);
  p.cqss = (float*)alloc((size_t)6 * R * 4); p.ckvss = (float*)alloc((size_t)4 * R * 4); p.KPE = (float*)alloc((size_t)R * 32 * 4);
  static int grid_blocks = 0;
  if (!grid_blocks) { int dev = 0, cus = 0, per_cu = 0; hipGetDevice(&dev); hipDeviceGetAttribute(&cus, hipDeviceAttributeMultiprocessorCount, dev);
    hipOccupancyMaxActiveBlocksPerMultiprocessor(&per_cu, mega, NTHR, 0); per_cu = 1; grid_blocks = cus * per_cu; }
  p.OB0 = (float*)alloc((size_t)R * 512 * 4);
  p.bar = (unsigned*)alloc((size_t)(XCD_BAR_WORDS + 4 * NAJ + 64) * 4); p.bflag = p.bar + XCD_BAR_WORDS; p.actr = p.bflag + 4 * NAJ;
  if (wo > ws_size) { fprintf(stderr, "workspace too small: need %zu have %zu\n", wo, ws_size); return; }
  for (int l = 0; l < 4; ++l) p.lam_init[l] = (float)(0.8 - 0.6 * exp(-0.3 * (double)l));
  (void)hipMemsetAsync(p.bar, 0, (size_t)(XCD_BAR_WORDS + 4 * NAJ + 64) * 4, stream);
#if MK_MULTI
  for (int ph = 0; ph < NPH; ++ph) { hipLaunchKernelGGL(mega, dim3(grid_blocks), dim3(NTHR), 0, stream, p, ph, ph + 1); }
#else
  int lo = 0, hi = NPH; void* args[] = {&p, &lo, &hi};
  hipError_t e = hipLaunchCooperativeKernel((void*)mega, dim3(grid_blocks), dim3(NTHR), args, 0, stream);
  if (e != hipSuccess) fprintf(stderr, "cooperative launch failed: %s (grid %d)\n", hipGetErrorString(e), grid_blocks);
#endif
}
```

```cpp
#include <hip/hip_runtime.h>
#include <hip/hip_cooperative_groups.h>
#include <cstdint>
#include <cstring>
#include <cstdio>
#include <cmath>
namespace cg = cooperative_groups;
#ifndef REP_UP
#define REP_UP 0
#endif
#ifndef REP_SYNC
#define REP_SYNC 0
#endif
#ifndef REP_ATT
#define REP_ATT 0
#endif

typedef unsigned short bf16_t;
typedef short bf16x8 __attribute__((ext_vector_type(8)));
typedef short s16x4 __attribute__((ext_vector_type(4)));
typedef float f32x16 __attribute__((ext_vector_type(16)));
typedef float f32x4 __attribute__((ext_vector_type(4)));
typedef unsigned u32x4 __attribute__((ext_vector_type(4)));
typedef unsigned u32x2 __attribute__((ext_vector_type(2)));

#define DI __device__ __forceinline__
#define MFMA32(a, b, c) __builtin_amdgcn_mfma_f32_32x32x16_bf16((a), (b), (c), 0, 0, 0)

constexpr int R = 16896, RP = 16384, DM = 1024, DFF = 2816, NL = 4;
constexpr int LDS_BYTES = 128 * 272 * 4;
constexpr int NTHR = 512;
constexpr int NAJ = 288;
constexpr float LOG2E = 1.4426950408889634f;
constexpr float EPS = 1e-6f;
constexpr int NPH = 2 + 10 * NL;
#ifndef MK_MINW
#define MK_MINW 2
#endif

DI unsigned pk2(float lo, float hi) { unsigned r; asm("v_cvt_pk_bf16_f32 %0, %1, %2" : "=v"(r) : "v"(lo), "v"(hi)); return r; }
DI float b2f(bf16_t b) { return __uint_as_float((unsigned)b << 16); }
DI int crow(int r, int hi) { return (r & 3) + 8 * (r >> 2) + 4 * hi; }
DI int ltid() { int t = threadIdx.x; asm volatile("" : "+v"(t)); return t; }


#define XB_TMO      128
#define XB_XCNT(j)  (256  + 64 * (j))
#define XB_XSUB(j)  (1280 + 64 * (j))
#define XB_XGEN(j)  (2304 + 64 * (j))
#define XB_TOP      3328
#define XB_TOPGEN   3392
#define XCD_BAR_WORDS 3456
#define XB_SPIN_CAP (1u << 18)
#define LAS __attribute__((address_space(3)))
DI unsigned xb_ld(unsigned* p)              { return __hip_atomic_load(p, __ATOMIC_RELAXED, __HIP_MEMORY_SCOPE_AGENT); }
DI unsigned xb_add(unsigned* p, unsigned v) { return __hip_atomic_fetch_add(p, v, __ATOMIC_RELAXED, __HIP_MEMORY_SCOPE_AGENT); }
DI unsigned xb_xcc_id() { return (unsigned)__builtin_amdgcn_s_getreg((3 << 11) | 20) & 0xFu; }
#define XB_SPIN(cond, bar) do { unsigned _sp = 0; while (cond) { __builtin_amdgcn_s_sleep(1); \
    if ((++_sp & 255u) == 0u) { if (xb_ld(&(bar)[XB_TMO])) break; if (_sp > XB_SPIN_CAP) { atomicAdd(&(bar)[XB_TMO], 1u); break; } } } } while (0)
struct XcdBarrier { unsigned* bar; unsigned x; volatile LAS unsigned* st; };
DI XcdBarrier xcd_barrier_post(unsigned* bar, volatile LAS unsigned* st) {
  XcdBarrier b; b.bar = bar; b.x = xb_xcc_id(); b.st = st;
  if (threadIdx.x == 0) (void)xb_add(&bar[XB_XCNT(b.x)], 1u);
  return b; }
DI void xcd_barrier_complete(unsigned* bar, unsigned x, unsigned& nloc, unsigned& nx) {
  const unsigned G = gridDim.x * gridDim.y * gridDim.z;
  unsigned sum, cnt, mine, sp = 0u;
  for (;;) {
    sum = 0u; cnt = 0u; mine = 0u;
#pragma unroll
    for (unsigned j = 0; j < 16; ++j) { const unsigned c = xb_ld(&bar[XB_XCNT(j)]); sum += c; cnt += (c > 0u) ? 1u : 0u; mine = (j == x) ? c : mine; }
    if (sum == G) break;
    __builtin_amdgcn_s_sleep(1);
    if ((++sp & 255u) == 0u) { if (xb_ld(&bar[XB_TMO])) break; if (sp > XB_SPIN_CAP) { atomicAdd(&bar[XB_TMO], 1u); break; } }
  }
  nloc = mine > 0u ? mine : 1u; nx = cnt > 0u ? cnt : 1u; }
DI void xcd_barrier(const XcdBarrier& b) {
  asm volatile("s_waitcnt vmcnt(0)" ::: "memory");
  __syncthreads();
  if (threadIdx.x == 0) {
    unsigned* bar = b.bar;
    __builtin_amdgcn_s_waitcnt(0);
    unsigned nloc = b.st[0], nx = b.st[1];
    if (nloc == 0u) { xcd_barrier_complete(bar, b.x, nloc, nx); b.st[0] = nloc; b.st[1] = nx; }
    const unsigned old = xb_add(&bar[XB_XSUB(b.x)], 1u);
    const unsigned gen = old / nloc;
    if (old + 1u == (gen + 1u) * nloc) {
      __builtin_amdgcn_fence(__ATOMIC_RELEASE, "agent");
      asm volatile("s_waitcnt vmcnt(0)" ::: "memory");
      const unsigned og = xb_add(&bar[XB_TOP], 1u);
      const unsigned tg = og / nx;
      if (og + 1u == (tg + 1u) * nx) xb_add(&bar[XB_TOPGEN], 1u);
      else XB_SPIN(xb_ld(&bar[XB_TOPGEN]) == tg, bar);
      __builtin_amdgcn_fence(__ATOMIC_ACQUIRE, "agent");
      xb_add(&bar[XB_XGEN(b.x)], 1u);
      asm volatile("s_waitcnt vmcnt(0)" ::: "memory");
    } else {
      XB_SPIN(xb_ld(&bar[XB_XGEN(b.x)]) == gen, bar);
      __builtin_amdgcn_fence(__ATOMIC_ACQUIRE, "agent");
      asm volatile("s_waitcnt vmcnt(0)" ::: "memory");
    }
  }
  __syncthreads();
}

struct Params {
  const float* in[43];
  float* out;
  long o_ys, o_pak, o_pav, o_pbk, o_pbv, o_pckv, o_pckpe, o_pmk, o_pmv, o_sak, o_sav, o_sbk, o_sbv, o_sckv, o_sckpe;
  bf16_t *Wgu1, *Wd1, *Win, *Wuq, *Wukv, *Wukvu, *Wout, *Wmq, *Wmkv, *Wmo, *Wgu2, *Wd2;
  bf16_t *Xb, *H, *OMIX, *OM, *QA, *QB, *QC, *QM, *CQraw, *CKVraw;
  bf16_t *PKA, *PVA, *PKB, *PVB, *PKC, *PVC;
  bf16_t *SKA, *SVA, *SKB, *SVB, *SKC, *SVC, *SKM, *SVM;
  bf16_t *MK, *MV, *MEMb, *CCKVb;
  float *ss, *memss, *cqss, *ckvss, *KPE, *OB0;
  unsigned* bar; unsigned* bflag; unsigned* actr;
  float lam_init[4];
};

DI float sumsq64(const float (&v)[64]) { float s = 0.f;
#pragma unroll
  for (int i = 0; i < 64; ++i) s += v[i] * v[i];
  return s; }
DI void store_bf16_64(bf16_t* dst, const float (&v)[64]) {
#pragma unroll
  for (int c = 0; c < 8; ++c) { u32x4 w; w.x = pk2(v[8 * c], v[8 * c + 1]); w.y = pk2(v[8 * c + 2], v[8 * c + 3]); w.z = pk2(v[8 * c + 4], v[8 * c + 5]); w.w = pk2(v[8 * c + 6], v[8 * c + 7]); *(u32x4*)(dst + 8 * c) = w; } }
DI void store_bf16_32(bf16_t* dst, const float (&v)[64]) {
#pragma unroll
  for (int c = 0; c < 4; ++c) { u32x4 w; w.x = pk2(v[8 * c], v[8 * c + 1]); w.y = pk2(v[8 * c + 2], v[8 * c + 3]); w.z = pk2(v[8 * c + 4], v[8 * c + 5]); w.w = pk2(v[8 * c + 6], v[8 * c + 7]); *(u32x4*)(dst + 8 * c) = w; } }
DI void store_f32_64(float* dst, const float (&v)[64]) {
#pragma unroll
  for (int c = 0; c < 16; ++c) { f32x4 w = {v[4 * c], v[4 * c + 1], v[4 * c + 2], v[4 * c + 3]}; *(f32x4*)(dst + 4 * c) = w; } }
DI void mulgain64(float (&v)[64], const float* g, float sc) {
#pragma unroll
  for (int c = 0; c < 16; ++c) { f32x4 w = *(const f32x4*)(g + 4 * c); v[4 * c] *= w.x * sc; v[4 * c + 1] *= w.y * sc; v[4 * c + 2] *= w.z * sc; v[4 * c + 3] *= w.w * sc; } }
DI void scale64(float (&v)[64], float sc) {
#pragma unroll
  for (int i = 0; i < 64; ++i) v[i] *= sc; }
DI float rstd_from(const float* ssp, int np, int stride, int row, float invn) { float s = 0.f; for (int q = 0; q < np; ++q) s += ssp[(size_t)q * stride + row]; return rsqrtf(s * invn + EPS); }
DI void rope32(float (&v)[64], int pos) {
  const float fp = (float)pos;
#pragma unroll
  for (int i = 0; i < 16; ++i) {
    const float inv = ((i & 3) == 0 ? 1.f : (i & 3) == 1 ? 0.5623413251903491f : (i & 3) == 2 ? 0.31622776601683794f : 0.17782794100389228f)
                    * ((i >> 2) == 0 ? 1.f : (i >> 2) == 1 ? 0.1f : (i >> 2) == 2 ? 0.01f : 0.001f);
    const float ang = fp * inv;
    float rev = ang * 0.15915494309189535f; rev -= floorf(rev);
    const float c = __builtin_amdgcn_cosf(rev), s = __builtin_amdgcn_sinf(rev);
    const float x1 = v[i], x2 = v[16 + i]; v[i] = x1 * c - x2 * s; v[16 + i] = x1 * s + x2 * c; } }

typedef int i32x4 __attribute__((ext_vector_type(4)));
DI int lds_byte2(int r, int c) { const int st = (r >> 4) * 2 + (c >> 5), ob = (r & 15) * 64 + (c & 31) * 2; return st * 1024 + (ob ^ (((ob >> 9) & 1) << 5)); }
DI void stage_rc2(int b, int& Rr, int& Cc) { const int st = b >> 10, sb = b & 1023, swz = sb ^ (((sb >> 9) & 1) << 5); Rr = (st >> 1) * 16 + swz / 64; Cc = (st & 1) * 32 + (swz % 64) / 2; }
constexpr int G_TILE_B = 256 * 64 * 2, G_STAGE_B = 2 * G_TILE_B;

template <int MT, class Epi>
DI void gemm_unit(char* smem, const bf16_t* __restrict__ A, int lda, const bf16_t* __restrict__ Bt, int ldb, int K, int row0, int col0, Epi epi) {
  const int tid = ltid(), wid = tid >> 6, lane = tid & 63, wr = wid >> 2, wc = wid & 3, fr = lane & 15, fq = lane >> 4;
  constexpr int GLA = MT / 2, GLB = 4;
  const bf16_t* Ab = A + (size_t)row0 * lda;
  const bf16_t* Bb = Bt + (size_t)col0 * ldb;
  int aoff[GLA], boff[GLB];
#pragma unroll
  for (int i = 0; i < GLA; ++i) { int rr, cc; stage_rc2(wid * 1024 + i * 8192 + lane * 16, rr, cc); aoff[i] = rr * lda + cc; }
#pragma unroll
  for (int i = 0; i < GLB; ++i) { int rr, cc; stage_rc2(wid * 1024 + i * 8192 + lane * 16, rr, cc); boff[i] = rr * ldb + cc; }
  f32x4 acc[MT][4];
#pragma unroll
  for (int m = 0; m < MT; ++m)
#pragma unroll
    for (int n = 0; n < 4; ++n) acc[m][n] = (f32x4){0.f, 0.f, 0.f, 0.f};
  i32x4 sa[GLA], sb[GLB];
#define U_SA(b) (smem + (b) * G_STAGE_B)
#define U_SB(b) (smem + (b) * G_STAGE_B + G_TILE_B)
#define U_ISSUE(kt) do { _Pragma("unroll") for (int i = 0; i < GLA; ++i) sa[i] = *(const i32x4*)(Ab + aoff[i] + (kt) * 64); \
    _Pragma("unroll") for (int i = 0; i < GLB; ++i) sb[i] = *(const i32x4*)(Bb + boff[i] + (kt) * 64); __builtin_amdgcn_sched_barrier(0); } while (0)
#define U_WRITE(buf) do { _Pragma("unroll") for (int i = 0; i < GLA; ++i) *(i32x4*)(U_SA(buf) + wid * 1024 + i * 8192 + lane * 16) = sa[i]; \
    _Pragma("unroll") for (int i = 0; i < GLB; ++i) *(i32x4*)(U_SB(buf) + wid * 1024 + i * 8192 + lane * 16) = sb[i]; } while (0)
#define U_RDA(m, buf, ks) (*(const bf16x8*)(U_SA(buf) + lds_byte2(wr * 16 * MT + (m) * 16 + fr, (ks) * 32 + fq * 8)))
#define U_MM(m, AR, BF) do { _Pragma("unroll") for (int n = 0; n < 4; ++n) acc[m][n] = __builtin_amdgcn_mfma_f32_16x16x32_bf16(BF[n], AR, acc[m][n], 0, 0, 0); } while (0)
#define U_SBAR __builtin_amdgcn_sched_barrier(0)
#define U_RDB(BF, buf, ks) do { _Pragma("unroll") for (int n = 0; n < 4; ++n) BF[n] = *(const bf16x8*)(U_SB(buf) + lds_byte2(wc * 64 + n * 16 + fr, (ks) * 32 + fq * 8)); } while (0)
#define U_KTILE(buf) do { bf16x8 Bf[4], Bg[4], A0, A1; \
    U_RDB(Bf, buf, 0); A0 = U_RDA(0, buf, 0); \
    _Pragma("unroll") for (int m = 0; m < MT; m += 2) { \
      A1 = U_RDA(m + 1, buf, 0); U_SBAR; U_MM(m, A0, Bf); U_SBAR; \
      if (m + 2 < MT) { A0 = U_RDA(m + 2, buf, 0); } else { U_RDB(Bg, buf, 1); A0 = U_RDA(0, buf, 1); } U_SBAR; U_MM(m + 1, A1, Bf); U_SBAR; } \
    _Pragma("unroll") for (int m = 0; m < MT; m += 2) { \
      A1 = U_RDA(m + 1, buf, 1); U_SBAR; U_MM(m, A0, Bg); U_SBAR; \
      if (m + 2 < MT) A0 = U_RDA(m + 2, buf, 1); U_SBAR; U_MM(m + 1, A1, Bg); U_SBAR; } } while (0)
  const int nt = K >> 6;
  float* rtab = (float*)(smem + 2 * G_STAGE_B);
  if constexpr (Epi::NEED_RSTD) { if (tid < 32 * MT) rtab[tid] = rstd_from(epi.ss, 16, R, row0 + tid, 1.f / 1024.f); }
  U_ISSUE(0); U_WRITE(0); U_ISSUE(1); __syncthreads();
#pragma unroll 1
  for (int t = 0; t < nt; ++t) { const int cur = t & 1;
    if (t + 1 < nt) U_WRITE(cur ^ 1);
    if (t + 2 < nt) U_ISSUE(t + 2);
    U_KTILE(cur);
    __syncthreads(); }
#undef U_SA
#undef U_SB
#undef U_ISSUE
#undef U_WRITE
#undef U_KTILE
#undef U_RDB
#undef U_RDA
#undef U_MM
#undef U_SBAR
  if constexpr (Epi::DIRECT) {
    epi.template direct<MT>(acc, row0, wr * 16 * MT, col0 + wc * 64, fr, fq, rtab);
    __syncthreads();
  } else {
    static_assert(MT <= 4, "LDS epilogue: the whole unit (<= 128 rows x 256 cols f32) is parked in LDS at once");
    float* Ct = (float*)smem;
#pragma unroll
    for (int m = 0; m < MT; ++m)
#pragma unroll
      for (int n = 0; n < 4; ++n) *(f32x4*)(Ct + (wr * 16 * MT + m * 16 + fr) * 272 + wc * 68 + n * 16 + fq * 4) = acc[m][n];
    __syncthreads();
    if (tid < 128 * MT) {
      const int row = tid >> 2, piece = tid & 3; float v[64];
      const float* src = Ct + row * 272 + piece * 68;
#pragma unroll
      for (int c = 0; c < 16; ++c) { const f32x4 t4 = *(const f32x4*)(src + 4 * c); v[4 * c] = t4.x; v[4 * c + 1] = t4.y; v[4 * c + 2] = t4.z; v[4 * c + 3] = t4.w; }
      epi.nt = (col0 >> 7) + (piece >> 1);
      epi(row0 + row, piece & 1, v);
    }
    __syncthreads();
  }
}

struct EpiFfnUp { const float* ss; bf16_t* H; int nt;
  static constexpr bool DIRECT = true, NEED_RSTD = true;
  template <int MT> DI void direct(const f32x4 (&acc)[MT][4], int row0, int lrow, int cbase, int fr, int fq, const float* rtab) const {
#pragma unroll
    for (int m = 0; m < MT; ++m) { const float rs = rtab[lrow + m * 16 + fr]; bf16_t* dst = H + (size_t)(row0 + lrow + m * 16 + fr) * DFF + (cbase >> 1) + fq * 4;
#pragma unroll
      for (int q = 0; q < 2; ++q) { float h[4];
#pragma unroll
        for (int j = 0; j < 4; ++j) { const float g = acc[m][2 * q][j] * rs, u = acc[m][2 * q + 1][j] * rs; h[j] = g * __builtin_amdgcn_rcpf(1.f + __expf(-g)) * u; }
        u32x2 w; w.x = pk2(h[0], h[1]); w.y = pk2(h[2], h[3]); *(u32x2*)(dst + q * 16) = w; } }
  }
  DI void operator()(int, int, float (&)[64]) const {} };

struct EpiResid { float* X; bf16_t* Xb; float* ss; int nt; float scale;
  static constexpr bool DIRECT = true, NEED_RSTD = false;
  template <int MT> DI void direct(const f32x4 (&acc)[MT][4], int row0, int lrow, int cbase, int fr, int fq, const float*) const {
#pragma unroll
    for (int m = 0; m < MT; ++m) { const int row = row0 + lrow + m * 16 + fr; float sq = 0.f;
      float* xp = X + (size_t)row * DM + cbase + fq * 4; bf16_t* bp = Xb + (size_t)row * DM + cbase + fq * 4;
#pragma unroll
      for (int n = 0; n < 4; ++n) { f32x4 x = *(const f32x4*)(xp + n * 16);
        x.x += scale * acc[m][n][0]; x.y += scale * acc[m][n][1]; x.z += scale * acc[m][n][2]; x.w += scale * acc[m][n][3];
        *(f32x4*)(xp + n * 16) = x; u32x2 w; w.x = pk2(x.x, x.y); w.y = pk2(x.z, x.w); *(u32x2*)(bp + n * 16) = w;
        sq += x.x * x.x + x.y * x.y + x.z * x.z + x.w * x.w; }
      sq += __shfl_xor(sq, 16); sq += __shfl_xor(sq, 32);
      if (fq == 0) ss[(size_t)(cbase >> 6) * R + row] = sq;
      if (m & 1) __builtin_amdgcn_sched_barrier(0); }
  }
  DI void operator()(int, int, float (&)[64]) const {} };

struct EpiProj { const Params* pp; int l; int nt;
  static constexpr bool DIRECT = false, NEED_RSTD = false;
  DI void operator()(int row, int half, float (&v)[64]) const {
    const Params& p = *pp;
    const bool samp = row >= RP; const int sr = row - RP; const int b = samp ? (sr >> 6) : (row >> 12); const int t = samp ? (sr & 63) : (row & 4095);
    scale64(v, rstd_from(p.ss, 16, R, row, 1.f / 1024.f));
    if (nt < 2) { const int head = 2 * nt + half; const float r2 = rsqrtf(sumsq64(v) * (1.f / 64.f) + EPS);
      mulgain64(v, p.in[17] + l * 64, r2 * 0.125f * LOG2E); store_bf16_64(p.QA + (size_t)row * 256 + head * 64, v);
    } else if (nt < 6) { const bool isk = nt < 4; const int head = 2 * (nt - (isk ? 2 : 4)) + half;
      if (isk) { const float r2 = rsqrtf(sumsq64(v) * (1.f / 64.f) + EPS); mulgain64(v, p.in[18] + l * 64, r2); }
      bf16_t* kb = isk ? (samp ? p.SKA : p.PKA) : (samp ? p.SVA : p.PVA);
      const size_t krow = samp ? ((size_t)(l * 8 + b) * 576 + 512 + t) : (size_t)row;
      store_bf16_64(kb + krow * 256 + head * 64, v);
      if (samp) store_f32_64(p.out + (isk ? p.o_sak : p.o_sav) + ((size_t)(l * 8 + b) * 64 + t) * 256 + head * 64, v);
      else if (t >= 3584) store_f32_64(p.out + (isk ? p.o_pak : p.o_pav) + ((size_t)(l * 4 + b) * 512 + (t - 3584)) * 256 + head * 64, v);
    } else if (nt < 10) { const int g = 2 * (nt - 6) + half; const float r2 = rsqrtf(sumsq64(v) * (1.f / 64.f) + EPS);
      mulgain64(v, p.in[20] + l * 64, r2 * 0.125f * LOG2E); store_bf16_64(p.QB + (size_t)row * 512 + g * 64, v);
    } else if (nt < 18) { const bool isk = nt < 14; const int col = isk ? (128 * (nt - 10) + 64 * half) : (128 * (nt - 14) + 64 * half);
      if (isk) { const float r2 = rsqrtf(sumsq64(v) * (1.f / 64.f) + EPS); mulgain64(v, p.in[21] + l * 64, r2); }
      bf16_t* kb = isk ? (samp ? p.SKB : p.PKB) : (samp ? p.SVB : p.PVB);
      const size_t krow = samp ? ((size_t)(l * 8 + b) * 2112 + 2048 + t) : (size_t)row;
      store_bf16_64(kb + krow * 512 + col, v);
      if (samp) store_f32_64(p.out + (isk ? p.o_sbk : p.o_sbv) + ((size_t)l * 512 + sr) * 512 + col, v);
      else store_f32_64(p.out + (isk ? p.o_pbk : p.o_pbv) + ((size_t)l * RP + row) * 512 + col, v);
    } else if (nt < 21) { const int col = 128 * (nt - 18) + 64 * half;
      store_bf16_64(p.CQraw + (size_t)row * 384 + col, v); p.cqss[(size_t)(2 * (nt - 18) + half) * R + row] = sumsq64(v);
    } else if (nt < 23) { const int col = 128 * (nt - 21) + 64 * half;
      store_bf16_64(p.CKVraw + (size_t)row * 256 + col, v); p.ckvss[(size_t)(2 * (nt - 21) + half) * R + row] = sumsq64(v);
      if (samp) store_f32_64(p.out + p.o_sckv + ((size_t)l * 512 + sr) * 256 + col, v);
      else store_f32_64(p.out + p.o_pckv + ((size_t)l * RP + row) * 256 + col, v);
    } else { if (half == 0) { rope32(v, samp ? 2048 + t : t);
        float* o = samp ? (p.out + p.o_sckpe + ((size_t)l * 512 + sr) * 32) : (p.out + p.o_pckpe + ((size_t)l * RP + row) * 32);
        float* kp = p.KPE + (size_t)row * 32;
#pragma unroll
        for (int c = 0; c < 8; ++c) { f32x4 w = {v[4 * c], v[4 * c + 1], v[4 * c + 2], v[4 * c + 3]}; *(f32x4*)(o + 4 * c) = w; *(f32x4*)(kp + 4 * c) = w; } } }
  } };

struct EpiQc { const Params* pp; int l; int nt;
  static constexpr bool DIRECT = false, NEED_RSTD = false;
  DI void operator()(int row, int half, float (&v)[64]) const {
    const Params& p = *pp; const int h = nt;
    const bool samp = row >= RP; const int sr = row - RP; const int t = samp ? (sr & 63) : (row & 4095);
    scale64(v, rstd_from(p.cqss, 6, R, row, 1.f / 384.f));
    float s;
    if (half) { rope32(v, samp ? 2048 + t : t); s = 0.f;
#pragma unroll
      for (int i = 0; i < 32; ++i) s += v[i] * v[i]; } else s = sumsq64(v);
    s += __shfl_xor(s, 1);
    const float r2 = rsqrtf(s * (1.f / 96.f) + EPS) * (0.10206207261596575f * LOG2E);
    const float* g = p.in[28] + l * 96 + half * 64; bf16_t* dst = p.QC + (size_t)row * 384 + h * 96 + half * 64;
    if (half == 0) { mulgain64(v, g, r2); store_bf16_64(dst, v); }
    else {
#pragma unroll
      for (int i = 0; i < 32; ++i) v[i] *= g[i] * r2;
      store_bf16_32(dst, v); }
  } };

struct EpiKv { const Params* pp; int l; int nt; int mode;
  static constexpr bool DIRECT = false, NEED_RSTD = false;
  DI void operator()(int row, int half, float (&v)[64]) const {
    const Params& p = *pp; const int h = nt;
    size_t krow; const float* kpe; float rs = 1.f;
    if (mode == 0) { const bool samp = row >= RP; const int sr = row - RP;
      krow = samp ? ((size_t)(l * 8 + (sr >> 6)) * 2112 + 2048 + (sr & 63)) : (size_t)row; kpe = p.KPE + (size_t)row * 32;
      rs = rstd_from(p.ckvss, 4, R, row, 1.f / 256.f);
      if (h == 0) {
        float* o = samp ? (p.out + p.o_sckv + ((size_t)l * 512 + sr) * 256) : (p.out + p.o_pckv + ((size_t)l * RP + row) * 256);
        const float* g = p.in[25] + l * 256;
        for (int c = 0; c < 32; ++c) { const int cc = half * 128 + 4 * c; f32x4 x = *(const f32x4*)(o + cc); const f32x4 gg = *(const f32x4*)(g + cc);
          x.x *= rs * gg.x; x.y *= rs * gg.y; x.z *= rs * gg.z; x.w *= rs * gg.w; *(f32x4*)(o + cc) = x; } }
    } else { const int b = row >> 11, pos = row & 2047; krow = (size_t)(l * 8 + b) * 2112 + pos; kpe = p.in[8] + ((size_t)(l * 8 + b) * 2048 + pos) * 32; }
    const bool tosamp = (mode == 1) || (row >= RP);
    scale64(v, rs);
    if (half == 0) { float kp[32]; float s = sumsq64(v);
#pragma unroll
      for (int c = 0; c < 8; ++c) { const f32x4 w = *(const f32x4*)(kpe + 4 * c); kp[4 * c] = w.x; kp[4 * c + 1] = w.y; kp[4 * c + 2] = w.z; kp[4 * c + 3] = w.w; s += w.x * w.x + w.y * w.y + w.z * w.z + w.w * w.w; }
      const float r2 = rsqrtf(s * (1.f / 96.f) + EPS); const float* g = p.in[29] + l * 96;
      mulgain64(v, g, r2);
      bf16_t* dst = (tosamp ? p.SKC : p.PKC) + krow * 384 + h * 96; store_bf16_64(dst, v);
#pragma unroll
      for (int c = 0; c < 4; ++c) { u32x4 w; w.x = pk2(kp[8 * c] * g[64 + 8 * c] * r2, kp[8 * c + 1] * g[65 + 8 * c] * r2); w.y = pk2(kp[8 * c + 2] * g[66 + 8 * c] * r2, kp[8 * c + 3] * g[67 + 8 * c] * r2);
        w.z = pk2(kp[8 * c + 4] * g[68 + 8 * c] * r2, kp[8 * c + 5] * g[69 + 8 * c] * r2); w.w = pk2(kp[8 * c + 6] * g[70 + 8 * c] * r2, kp[8 * c + 7] * g[71 + 8 * c] * r2); *(u32x4*)(dst + 64 + 8 * c) = w; }
    } else { store_bf16_64((tosamp ? p.SVC : p.PVC) + krow * 256 + h * 64, v); }
  } };

struct EpiMemQ { const Params* pp; int l; int nt;
  static constexpr bool DIRECT = false, NEED_RSTD = false;
  DI void operator()(int row, int half, float (&v)[64]) const {
    const Params& p = *pp; const int h = nt;
    scale64(v, rstd_from(p.ss, 16, R, row, 1.f / 1024.f));
    float s = sumsq64(v); s += __shfl_xor(s, 1);
    const float r2 = rsqrtf(s * (1.f / 128.f) + EPS) * (0.08838834764831845f * LOG2E);
    mulgain64(v, p.in[33] + l * 128 + half * 64, r2);
    store_bf16_64(p.QM + (size_t)row * 512 + h * 128 + half * 64, v);
  } };

struct EpiMemKV { const Params* pp; int l; int nt;
  static constexpr bool DIRECT = false, NEED_RSTD = false;
  DI void operator()(int row, int half, float (&v)[64]) const {
    const Params& p = *pp;
    scale64(v, rstd_from(p.memss, 16, 1024, row, 1.f / 1024.f));
    const size_t idx = ((size_t)l * 1024 + row) * 512 + (nt & 3) * 128 + half * 64;
    if (nt < 4) { float s = sumsq64(v); s += __shfl_xor(s, 1); const float r2 = rsqrtf(s * (1.f / 128.f) + EPS);
      mulgain64(v, p.in[37] + l * 128 + half * 64, r2); store_f32_64(p.out + p.o_pmk + idx, v); store_bf16_64(p.MK + idx, v);
    } else { store_f32_64(p.out + p.o_pmv + idx, v); store_bf16_64(p.MV + idx, v); }
  } };

typedef __attribute__((address_space(3))) const char* lds_cptr;
typedef short v4i16_t __attribute__((ext_vector_type(4)));
DI s16x4 vtr(const char* p) { return __builtin_bit_cast(s16x4, __builtin_amdgcn_ds_read_tr16_b64_v4i16((__attribute__((address_space(3))) v4i16_t*)(p))); }

constexpr int ATT_VOFF = 17408, ATT_STAGE = 17408 + 16384, ATT_TAB = 2 * ATT_STAGE;

template <int DQK, int DV, int MODE, bool PF = true>
DI void attn_core(char* smem, const bf16_t* Qrow, const bf16_t* __restrict__ Kb, int ldk, const bf16_t* __restrict__ Vb, int ldv,
                  int T0, int T1, int wlo, int whi, bool active, int qpos, int kpos0, float slope, f32x16 (&o)[DV / 32]) {
  const int tid = ltid(), lane = tid & 63, r32 = lane & 31, hi = lane >> 5;
  constexpr int KSTR = DQK * 2 + 16, KCH = DQK / 8, VCH = DV / 8, NKI = (64 * KCH + NTHR - 1) / NTHR, NVI = (64 * VCH + NTHR - 1) / NTHR, KTOT = 64 * KCH, VTOT = 64 * VCH, NKS = DQK / 16, NDH = DV / 32;
  bf16x8 qr[NKS];
#pragma unroll
  for (int ks = 0; ks < NKS; ++ks) { if (active) qr[ks] = *(const bf16x8*)(Qrow + ks * 16 + hi * 8); else qr[ks] = (bf16x8){0, 0, 0, 0, 0, 0, 0, 0}; }
#pragma unroll
  for (int d = 0; d < NDH; ++d)
#pragma unroll
    for (int i = 0; i < 16; ++i) o[d][i] = 0.f;
  float mhat = 0.f, lsum = 0.f;
  u32x4 kr[NKI], vr[NVI];
  int koff[NKI], voff[NVI]; int klds[NKI], vlds[NVI];
#pragma unroll
  for (int i = 0; i < NKI; ++i) { const int idx = min(tid + NTHR * i, KTOT - 1), key = idx / KCH, ch = idx % KCH; koff[i] = key * ldk + ch * 8; klds[i] = key * KSTR + ch * 16; }
#pragma unroll
  for (int i = 0; i < NVI; ++i) { const int idx = min(tid + NTHR * i, VTOT - 1), key = idx / VCH, ch = idx % VCH; voff[i] = key * ldv + ch * 8; vlds[i] = ATT_VOFF + (ch >> 2) * 4096 + key * 64 + (ch & 3) * 16; }
  const float* tab = (const float*)(smem + ATT_TAB);
  if (PF) {
    if (T0 < T1) {
#pragma unroll
      for (int i = 0; i < NKI; ++i) kr[i] = *(const u32x4*)(Kb + (size_t)T0 * 64 * ldk + koff[i]);
#pragma unroll
      for (int i = 0; i < NVI; ++i) vr[i] = *(const u32x4*)(Vb + (size_t)T0 * 64 * ldv + voff[i]);
#pragma unroll
      for (int i = 0; i < NKI; ++i) *(u32x4*)(smem + klds[i]) = kr[i];
#pragma unroll
      for (int i = 0; i < NVI; ++i) *(u32x4*)(smem + vlds[i]) = vr[i];
      if (T0 + 1 < T1) {
#pragma unroll
        for (int i = 0; i < NKI; ++i) kr[i] = *(const u32x4*)(Kb + (size_t)(T0 + 1) * 64 * ldk + koff[i]);
#pragma unroll
        for (int i = 0; i < NVI; ++i) vr[i] = *(const u32x4*)(Vb + (size_t)(T0 + 1) * 64 * ldv + voff[i]);
      }
    }
    __syncthreads();
#pragma unroll 1
    for (int t = T0; t < T1; ++t) {
      const int cur = (t - T0) & 1;
      const char* sbuf = smem + cur * ATT_STAGE;
      if (t + 1 < T1) {
        char* nb = smem + (cur ^ 1) * ATT_STAGE;
#pragma unroll
        for (int i = 0; i < NKI; ++i) *(u32x4*)(nb + klds[i]) = kr[i];
#pragma unroll
        for (int i = 0; i < NVI; ++i) *(u32x4*)(nb + vlds[i]) = vr[i];
      }
      if (t + 2 < T1) {
#pragma unroll
        for (int i = 0; i < NKI; ++i) kr[i] = *(const u32x4*)(Kb + (size_t)(t + 2) * 64 * ldk + koff[i]);
#pragma unroll
        for (int i = 0; i < NVI; ++i) vr[i] = *(const u32x4*)(Vb + (size_t)(t + 2) * 64 * ldv + voff[i]);
      }
  if (active && t >= wlo && t < whi) {
        f32x16 s0, s1;
#pragma unroll
        for (int i = 0; i < 16; ++i) { s0[i] = 0.f; s1[i] = 0.f; }
        const char* kp = sbuf + r32 * KSTR + hi * 16;
#pragma unroll
        for (int ks = 0; ks < NKS; ++ks) {
          const bf16x8 k0 = *(const bf16x8*)(kp + ks * 32), k1 = *(const bf16x8*)(kp + 32 * KSTR + ks * 32);
          s0 = MFMA32(k0, qr[ks], s0); s1 = MFMA32(k1, qr[ks], s1); }
        __builtin_amdgcn_sched_barrier(0);
        if (MODE != 0) {
          const int dbase = qpos - (kpos0 + 64 * t + 4 * hi); const float fdb = (float)dbase;
#pragma unroll
          for (int i = 0; i < 16; ++i) { const int d0 = dbase - ((i & 3) + 8 * (i >> 2)), d1 = d0 - 32;
            if (MODE == 1) { const int i0 = min(max(d0, -128), 128) + 128, i1 = min(max(d1, -128), 128) + 128; s0[i] += tab[i0]; s1[i] += tab[i1]; }
            else { s0[i] -= slope * fabsf(fdb - (float)((i & 3) + 8 * (i >> 2))); s1[i] -= slope * fabsf(fdb - (float)(32 + (i & 3) + 8 * (i >> 2))); } }
        }
        float mx = fmaxf(s0[0], s1[0]);
#pragma unroll
        for (int i = 1; i < 16; ++i) mx = fmaxf(mx, fmaxf(s0[i], s1[i]));
        mx = fmaxf(mx, __shfl_xor(mx, 32));
        if (t == wlo) mhat = mx;
        else { const float g = mx - mhat;
          if (__any(g > 8.f)) { const float dl = fmaxf(g, 0.f); mhat += dl; const float f = __builtin_amdgcn_exp2f(-dl); lsum *= f;
#pragma unroll
            for (int i = 0; i < 16; ++i) { const float fr = __shfl(f, crow(i, hi));
#pragma unroll
              for (int d = 0; d < NDH; ++d) o[d][i] *= fr; } } }
        float ls = 0.f;
#pragma unroll
        for (int i = 0; i < 16; ++i) { s0[i] = __builtin_amdgcn_exp2f(s0[i] - mhat); s1[i] = __builtin_amdgcn_exp2f(s1[i] - mhat); ls += s0[i] + s1[i]; }
        lsum += ls;
        u32x4 pw[4];
#pragma unroll
        for (int c = 0; c < 4; ++c) { pw[0][c] = pk2(s0[2 * c], s0[2 * c + 1]); pw[1][c] = pk2(s0[8 + 2 * c], s0[9 + 2 * c]); pw[2][c] = pk2(s1[2 * c], s1[2 * c + 1]); pw[3][c] = pk2(s1[8 + 2 * c], s1[9 + 2 * c]); }
        __builtin_amdgcn_sched_barrier(0);
        const char* vp = sbuf + ATT_VOFF + ((lane >> 4) & 1) * 32 + (lane & 3) * 8 + (4 * hi + ((lane & 15) >> 2)) * 64;
#pragma unroll
        for (int s = 0; s < 4; ++s) {
          const bf16x8 pa = __builtin_bit_cast(bf16x8, pw[s]);
#pragma unroll
          for (int d = 0; d < NDH; ++d) {
            const s16x4 lo = vtr(vp + d * 4096 + s * 1024), hh = vtr(vp + d * 4096 + s * 1024 + 512);
            const bf16x8 vf = {lo[0], lo[1], lo[2], lo[3], hh[0], hh[1], hh[2], hh[3]};
            o[d] = MFMA32(pa, vf, o[d]); }
          __builtin_amdgcn_sched_barrier(0); }
      }
      __syncthreads();
    }
  } else {
#pragma unroll 1
    for (int t = T0; t < T1; ++t) {
#pragma unroll
      for (int i = 0; i < NKI; ++i) kr[i] = *(const u32x4*)(Kb + (size_t)t * 64 * ldk + koff[i]);
#pragma unroll
      for (int i = 0; i < NVI; ++i) vr[i] = *(const u32x4*)(Vb + (size_t)t * 64 * ldv + voff[i]);
      __syncthreads();
#pragma unroll
      for (int i = 0; i < NKI; ++i) *(u32x4*)(smem + klds[i]) = kr[i];
#pragma unroll
      for (int i = 0; i < NVI; ++i) *(u32x4*)(smem + vlds[i]) = vr[i];
      __syncthreads();
      const char* sbuf = smem;
  if (active && t >= wlo && t < whi) {
        f32x16 s0, s1;
#pragma unroll
        for (int i = 0; i < 16; ++i) { s0[i] = 0.f; s1[i] = 0.f; }
        const char* kp = sbuf + r32 * KSTR + hi * 16;
#pragma unroll
        for (int ks = 0; ks < NKS; ++ks) {
          const bf16x8 k0 = *(const bf16x8*)(kp + ks * 32), k1 = *(const bf16x8*)(kp + 32 * KSTR + ks * 32);
          s0 = MFMA32(k0, qr[ks], s0); s1 = MFMA32(k1, qr[ks], s1); }
        __builtin_amdgcn_sched_barrier(0);
        if (MODE != 0) {
          const int dbase = qpos - (kpos0 + 64 * t + 4 * hi); const float fdb = (float)dbase;
#pragma unroll
          for (int i = 0; i < 16; ++i) { const int d0 = dbase - ((i & 3) + 8 * (i >> 2)), d1 = d0 - 32;
            if (MODE == 1) { const int i0 = min(max(d0, -128), 128) + 128, i1 = min(max(d1, -128), 128) + 128; s0[i] += tab[i0]; s1[i] += tab[i1]; }
            else { s0[i] -= slope * fabsf(fdb - (float)((i & 3) + 8 * (i >> 2))); s1[i] -= slope * fabsf(fdb - (float)(32 + (i & 3) + 8 * (i >> 2))); } }
        }
        float mx = fmaxf(s0[0], s1[0]);
#pragma unroll
        for (int i = 1; i < 16; ++i) mx = fmaxf(mx, fmaxf(s0[i], s1[i]));
        mx = fmaxf(mx, __shfl_xor(mx, 32));
        if (t == wlo) mhat = mx;
        else { const float g = mx - mhat;
          if (__any(g > 8.f)) { const float dl = fmaxf(g, 0.f); mhat += dl; const float f = __builtin_amdgcn_exp2f(-dl); lsum *= f;
#pragma unroll
            for (int i = 0; i < 16; ++i) { const float fr = __shfl(f, crow(i, hi));
#pragma unroll
              for (int d = 0; d < NDH; ++d) o[d][i] *= fr; } } }
        float ls = 0.f;
#pragma unroll
        for (int i = 0; i < 16; ++i) { s0[i] = __builtin_amdgcn_exp2f(s0[i] - mhat); s1[i] = __builtin_amdgcn_exp2f(s1[i] - mhat); ls += s0[i] + s1[i]; }
        lsum += ls;
        u32x4 pw[4];
#pragma unroll
        for (int c = 0; c < 4; ++c) { pw[0][c] = pk2(s0[2 * c], s0[2 * c + 1]); pw[1][c] = pk2(s0[8 + 2 * c], s0[9 + 2 * c]); pw[2][c] = pk2(s1[2 * c], s1[2 * c + 1]); pw[3][c] = pk2(s1[8 + 2 * c], s1[9 + 2 * c]); }
        __builtin_amdgcn_sched_barrier(0);
        const char* vp = sbuf + ATT_VOFF + ((lane >> 4) & 1) * 32 + (lane & 3) * 8 + (4 * hi + ((lane & 15) >> 2)) * 64;
#pragma unroll
        for (int s = 0; s < 4; ++s) {
          const bf16x8 pa = __builtin_bit_cast(bf16x8, pw[s]);
#pragma unroll
          for (int d = 0; d < NDH; ++d) {
            const s16x4 lo = vtr(vp + d * 4096 + s * 1024), hh = vtr(vp + d * 4096 + s * 1024 + 512);
            const bf16x8 vf = {lo[0], lo[1], lo[2], lo[3], hh[0], hh[1], hh[2], hh[3]};
            o[d] = MFMA32(pa, vf, o[d]); }
          __builtin_amdgcn_sched_barrier(0); }
      }
    }
  }
  if (active) {
    lsum += __shfl_xor(lsum, 32);
    const float linv = 1.f / lsum;
#pragma unroll
    for (int i = 0; i < 16; ++i) { const float li = __shfl(linv, crow(i, hi));
#pragma unroll
      for (int d = 0; d < NDH; ++d) o[d][i] *= li; }
  }
}

template <int NDH>
DI void store_o(bf16_t* dst  , int ld, const f32x16 (&o)[NDH], int r32, int hi) {
#pragma unroll
  for (int i = 0; i < 16; ++i) { bf16_t* rp = dst + (size_t)crow(i, hi) * ld + r32;
#pragma unroll
    for (int d = 0; d < NDH; ++d) rp[32 * d] = (bf16_t)(pk2(o[d][i], 0.f) & 0xffffu); }
}

DI void attn_job(char* smem, const Params& p, int l, int kind, bool samp, int b, int h, int qt, int q) {
  const int tid = ltid(), lane = tid & 63, wid = tid >> 6, r32 = lane & 31, hi = lane >> 5, ch4 = wid >> 1;
  const int row0 = samp ? (RP + 64 * b) : (b * 4096 + 256 * qt);
  const int wrow = row0 + 32 * wid;
  const bool active = samp ? (wid < 2) : true;
  const int qpos = (samp ? 2048 : 256 * qt) + 32 * wid + r32;
  const int cq = 4 * qt + ch4;
  __syncthreads();
  if (kind == 0) {
    { float* tab = (float*)(smem + ATT_TAB); const float* src = p.in[19] + (size_t)(l * 4 + h) * 257; for (int i = tid; i < 257; i += NTHR) tab[i] = src[i] * LOG2E; }
    int T0, T1, wlo, whi, kpos0; const bf16_t *K, *V;
    if (samp) { T0 = 0; T1 = 9; wlo = 0; whi = 9; kpos0 = 1536; K = p.SKA + (size_t)(l * 8 + b) * 576 * 256 + h * 64; V = p.SVA + (size_t)(l * 8 + b) * 576 * 256 + h * 64; }
    else { T0 = max(0, 4 * qt - 8); T1 = 4 * qt + 4; wlo = max(0, cq - 8); whi = cq + 1; kpos0 = 0; K = p.PKA + (size_t)b * 4096 * 256 + h * 64; V = p.PVA + (size_t)b * 4096 * 256 + h * 64; }
    f32x16 o[2];
    attn_core<64, 64, 1>(smem, p.QA + (size_t)(wrow + r32) * 256 + h * 64, K, 256, V, 256, T0, T1, wlo, whi, active, qpos, kpos0, 0.f, o);
    if (active) store_o<2>(p.OMIX + (size_t)wrow * 1024 + h * 64, 1024, o, r32, hi);
  } else if (kind == 2) {
    const bf16_t *K, *V; int T1, whi;
    if (samp) { T1 = 33; whi = 33; K = p.SKC + (size_t)(l * 8 + b) * 2112 * 384 + h * 96; V = p.SVC + (size_t)(l * 8 + b) * 2112 * 256 + h * 64; }
    else { T1 = 4 * qt + 4; whi = cq + 1; K = p.PKC + (size_t)b * 4096 * 384 + h * 96; V = p.PVC + (size_t)b * 4096 * 256 + h * 64; }
    f32x16 o[2];
    attn_core<96, 64, 0>(smem, p.QC + (size_t)(wrow + r32) * 384 + h * 96, K, 384, V, 256, 0, T1, 0, whi, active, qpos, 0, 0.f, o);
    if (active) store_o<2>(p.OMIX + (size_t)wrow * 1024 + 768 + h * 64, 1024, o, r32, hi);
  } else {
    const bf16_t *K, *V; int T1, whi;
    if (samp) { T1 = 33; whi = 33; K = p.SKB + (size_t)(l * 8 + b) * 2112 * 512; V = p.SVB + (size_t)(l * 8 + b) * 2112 * 512 + h * 128; }
    else { T1 = 4 * qt + 4; whi = cq + 1; K = p.PKB + (size_t)b * 4096 * 512; V = p.PVB + (size_t)b * 4096 * 512 + h * 128; }
    const float slope = exp2f(-2.f * (float)(h + 1)) * LOG2E;
    const int jj = (kind == 3) ? 1 : 0;
    f32x16 o[4];
    attn_core<64, 128, 2>(smem, p.QB + (size_t)(wrow + r32) * 512 + (h * 2 + jj) * 64, K + (h * 2 + jj) * 64, 512, V, 512, 0, T1, 0, whi, active, qpos, 0, slope, o);
    float* ob = p.OB0 + (size_t)wrow * 512 + h * 128 + r32;
    unsigned* flag = p.bflag + l * NAJ + q;
    if (jj == 0) {
      if (active) {
#pragma unroll
        for (int i = 0; i < 16; ++i)
#pragma unroll
          for (int d = 0; d < 4; ++d) ob[(size_t)crow(i, hi) * 512 + 32 * d] = o[d][i];
      }
      asm volatile("s_waitcnt vmcnt(0)" ::: "memory");
      __syncthreads();
      if (tid == 0) { __builtin_amdgcn_fence(__ATOMIC_RELEASE, "agent"); asm volatile("s_waitcnt vmcnt(0)" ::: "memory");
        __hip_atomic_store(flag, 1u, __ATOMIC_RELAXED, __HIP_MEMORY_SCOPE_AGENT); }
    } else {
      float lam;
      { const float* bl = p.in[22] + (size_t)l * 256; float p1 = bl[lane] * bl[64 + lane], p2 = bl[128 + lane] * bl[192 + lane];
#pragma unroll
        for (int m = 1; m < 64; m <<= 1) { p1 += __shfl_xor(p1, m); p2 += __shfl_xor(p2, m); }
        lam = expf(p1) - expf(p2) + p.lam_init[l]; }
      if (tid == 0) { unsigned sp = 0u; while (__hip_atomic_load(flag, __ATOMIC_RELAXED, __HIP_MEMORY_SCOPE_AGENT) == 0u && ++sp < (1u << 20)) __builtin_amdgcn_s_sleep(2);
        __builtin_amdgcn_fence(__ATOMIC_ACQUIRE, "agent"); asm volatile("s_waitcnt vmcnt(0)" ::: "memory"); }
      __syncthreads();
      if (active) {
        const float* gsub = p.in[23] + l * 128; const float omz = 1.f - p.lam_init[l];
#pragma unroll
        for (int i = 0; i < 16; ++i)
#pragma unroll
          for (int d = 0; d < 4; ++d) o[d][i] = ob[(size_t)crow(i, hi) * 512 + 32 * d] - lam * o[d][i];
#pragma unroll
        for (int i = 0; i < 16; ++i) { float sq = o[0][i] * o[0][i] + o[1][i] * o[1][i] + o[2][i] * o[2][i] + o[3][i] * o[3][i];
          sq += __shfl_xor(sq, 1); sq += __shfl_xor(sq, 2); sq += __shfl_xor(sq, 4); sq += __shfl_xor(sq, 8); sq += __shfl_xor(sq, 16);
          const float r2 = rsqrtf(sq * (1.f / 128.f) + EPS) * omz;
#pragma unroll
          for (int d = 0; d < 4; ++d) o[d][i] *= r2 * gsub[32 * d + r32]; }
        store_o<4>(p.OMIX + (size_t)wrow * 1024 + 256 + h * 128, 1024, o, r32, hi);
      }
    }
  }
}

DI void mem_attn(char* smem, const Params& p, int l, int row0, int nrows, int h, const bf16_t* K, const bf16_t* V) {
  const int tid = ltid(), lane = tid & 63, wid = tid >> 6, r32 = lane & 31, hi = lane >> 5;
  const bool active = 32 * wid < nrows; const int wrow = row0 + 32 * wid;
  f32x16 o[4];
  __syncthreads();
  attn_core<128, 128, 0, false>(smem, p.QM + (size_t)(wrow + r32) * 512 + h * 128, K + h * 128, 512, V + h * 128, 512, 0, 4, 0, 4, active, 0, 0, 0.f, o);
  if (active) store_o<4>(p.OM + (size_t)wrow * 512 + h * 128, 512, o, r32, hi);
}

constexpr int WT_PER_LAYER = 352 * 2 + 176 * 2 + 192 + 12 + 8 + 8 + 64 + 32 + 64 + 32;
DI void wt_job(char* smem, const Params& p, int job) {
  const int l = job / WT_PER_LAYER; int r = job % WT_PER_LAYER;
  bf16_t* dst; int K, ntk, map; const float* gain = nullptr; const float* s0; const float* s1 = nullptr; int ldsrc;
  if (r < 352) { dst = p.Wgu1 + (size_t)l * 5632 * 1024; K = 1024; map = 1; gain = p.in[11] + l * 1024; s0 = p.in[12] + (size_t)l * 1024 * 2816; s1 = p.in[13] + (size_t)l * 1024 * 2816; ldsrc = 2816; }
  else if ((r -= 352) < 176) { dst = p.Wd1 + (size_t)l * 1024 * 2816; K = 2816; map = 0; s0 = p.in[14] + (size_t)l * 2816 * 1024; ldsrc = 1024; }
  else if ((r -= 176) < 192) { dst = p.Win + (size_t)l * 3072 * 1024; K = 1024; map = 0; gain = p.in[15] + l * 1024; s0 = p.in[16] + (size_t)l * 1024 * 2976; ldsrc = 2976; }
  else if ((r -= 192) < 12) { dst = p.Wuq + (size_t)l * 512 * 384; K = 384; map = 2; gain = p.in[24] + l * 384; s0 = p.in[26] + (size_t)l * 384 * 384; ldsrc = 384; }
  else if ((r -= 12) < 8) { dst = p.Wukv + (size_t)l * 512 * 256; K = 256; map = 0; gain = p.in[25] + l * 256; s0 = p.in[27] + (size_t)l * 256 * 512; ldsrc = 512; }
  else if ((r -= 8) < 8) { dst = p.Wukvu + (size_t)l * 512 * 256; K = 256; map = 0; s0 = p.in[27] + (size_t)l * 256 * 512; ldsrc = 512; }
  else if ((r -= 8) < 64) { dst = p.Wout + (size_t)l * 1024 * 1024; K = 1024; map = 0; s0 = p.in[30] + (size_t)l * 1024 * 1024; ldsrc = 1024; }
  else if ((r -= 64) < 32) { dst = p.Wmq + (size_t)l * 512 * 1024; K = 1024; map = 0; gain = p.in[31] + l * 1024; s0 = p.in[32] + (size_t)l * 1024 * 512; ldsrc = 512; }
  else if ((r -= 32) < 64) { dst = p.Wmkv + (size_t)l * 1024 * 1024; K = 1024; map = 3; gain = p.in[34] + l * 1024; s0 = p.in[35] + (size_t)l * 1024 * 512; s1 = p.in[36] + (size_t)l * 1024 * 512; ldsrc = 512; }
  else if ((r -= 64) < 32) { dst = p.Wmo + (size_t)l * 1024 * 512; K = 512; map = 0; s0 = p.in[38] + (size_t)l * 512 * 1024; ldsrc = 1024; }
  else if ((r -= 32) < 352) { dst = p.Wgu2 + (size_t)l * 5632 * 1024; K = 1024; map = 1; gain = p.in[39] + l * 1024; s0 = p.in[40] + (size_t)l * 1024 * 2816; s1 = p.in[41] + (size_t)l * 1024 * 2816; ldsrc = 2816; }
  else { r -= 352; dst = p.Wd2 + (size_t)l * 1024 * 2816; K = 2816; map = 0; s0 = p.in[42] + (size_t)l * 2816 * 1024; ldsrc = 1024; }
  ntk = K >> 6;
  const int n0 = (r / ntk) * 256, k0 = (r % ntk) * 64;
  const int tid = ltid();
  float* lf = (float*)smem;
  { const int c4 = tid & 63, kq = tid >> 6; const int np = n0 + 4 * c4; const float* src = s0; int col;
    if (map == 0) col = np < ldsrc ? np : -1;
    else if (map == 1) { const int w = np & 63, sub = w >> 4; col = (np >> 6) * 32 + (sub >> 1) * 16 + (w & 15); if (sub & 1) src = s1; }
    else if (map == 2) { col = (np & 127) < 96 ? (np >> 7) * 96 + (np & 127) : -1; }
    else { if (np < 512) col = np; else { col = np - 512; src = s1; } }
#pragma unroll
    for (int i = 0; i < 8; ++i) { const int kl = kq + 8 * i; f32x4 x = {0.f, 0.f, 0.f, 0.f};
      if (col >= 0) { x = *(const f32x4*)(src + (size_t)(k0 + kl) * ldsrc + col); if (gain) { const float g = gain[k0 + kl]; x.x *= g; x.y *= g; x.z *= g; x.w *= g; } }
      *(f32x4*)(lf + kl * 260 + 4 * c4) = x; } }
  __syncthreads();
  { const int nl = tid >> 1, kh = (tid & 1) * 32; float x[32];
#pragma unroll
    for (int j = 0; j < 32; ++j) x[j] = lf[(kh + j) * 260 + nl];
    bf16_t* d = dst + (size_t)(n0 + nl) * K + k0 + kh;
#pragma unroll
    for (int c = 0; c < 4; ++c) { u32x4 w = {pk2(x[8 * c], x[8 * c + 1]), pk2(x[8 * c + 2], x[8 * c + 3]), pk2(x[8 * c + 4], x[8 * c + 5]), pk2(x[8 * c + 6], x[8 * c + 7])}; *(u32x4*)(d + 8 * c) = w; } }
  __syncthreads();
}

DI void rowprep_job(const Params& p, int job, bool mem) {
  const int tid = ltid(), lane = tid & 63, wid = tid >> 6; const int row = 8 * job + wid;
  const float* src = mem ? (p.in[2] + (size_t)row * DM) : (row < RP ? p.in[0] + (size_t)row * DM : p.in[1] + (size_t)(row - RP) * DM);
  f32x4 x[4]; float s = 0.f;
#pragma unroll
  for (int c = 0; c < 4; ++c) { x[c] = *(const f32x4*)(src + lane * 16 + 4 * c); s += x[c].x * x[c].x + x[c].y * x[c].y + x[c].z * x[c].z + x[c].w * x[c].w; }
  if (!mem) {
#pragma unroll
    for (int c = 0; c < 4; ++c) *(f32x4*)(p.out + (size_t)row * DM + lane * 16 + 4 * c) = x[c]; }
  bf16_t* d = (mem ? p.MEMb : p.Xb) + (size_t)row * DM + lane * 16;
  u32x4 w0 = {pk2(x[0].x, x[0].y), pk2(x[0].z, x[0].w), pk2(x[1].x, x[1].y), pk2(x[1].z, x[1].w)}, w1 = {pk2(x[2].x, x[2].y), pk2(x[2].z, x[2].w), pk2(x[3].x, x[3].y), pk2(x[3].z, x[3].w)};
  *(u32x4*)d = w0; *(u32x4*)(d + 8) = w1;
  s += __shfl_xor(s, 1); s += __shfl_xor(s, 2);
  if ((lane & 3) == 0) { if (mem) p.memss[(size_t)(lane >> 2) * 1024 + row] = s; else p.ss[(size_t)(lane >> 2) * R + row] = s; }
}

DI void conv_job(const float* src, bf16_t* dst, int job, int chunk, int dstride) {
  const size_t e = (size_t)job * 4096 + ltid() * 8;
  const f32x4 a = *(const f32x4*)(src + e), b = *(const f32x4*)(src + e + 4);
  u32x4 w = {pk2(a.x, a.y), pk2(a.z, a.w), pk2(b.x, b.y), pk2(b.z, b.w)};
  const size_t q = e / (size_t)chunk, rm = e % (size_t)chunk;
  *(u32x4*)(dst + q * (size_t)dstride + rm) = w;
}


DI void gemm_decode(int j, int MT, int NT, int& m, int& n) {
  const int rowsz = 8 * NT, sm = j / rowsz, jr = j - sm * rowsz, rows = min(8, MT - 8 * sm), nfull = NT >> 3, blk = rows * 8;
  int sn, w, local;
  if (jr < nfull * blk) { sn = jr / blk; w = 8; local = jr - sn * blk; } else { sn = nfull; w = NT - 8 * nfull; local = jr - nfull * blk; }
  const int ni = local / rows; m = 8 * sm + (local - ni * rows); n = 8 * sn + ni; }
DI bool gemm_job(int it, int MT, int NT, int& m, int& n) {
  const int G = gridDim.x, bid = blockIdx.x, per = G >> 3;
  if (it >= (MT * NT) / G) return false;
  gemm_decode((it * 8 + (bid & 7)) * per + (bid >> 3), MT, NT, m, n); return true; }
DI bool gemm_tail(int it, int MT, int NT, int& m, int& n, int& half) {
  const int G = gridDim.x, t = blockIdx.x + it * G, tot = MT * NT, base = (tot / G) * G, L = tot - base;
  if (t >= 2 * L) return false;
  gemm_decode(base + (t >> 1), MT, NT, m, n); half = t & 1; return true; }

template <int SEL>
DI void run_phase(const Params& p, char* smem, int ph) {
  const int G = gridDim.x, bid = blockIdx.x;
#ifdef ONLY_S
  if (ph < 2 && ONLY_S < 10) return;
  if (ph >= 2 && ONLY_S >= 10) return;
#endif
  if (ph == 0) {
    constexpr int NWT = WT_PER_LAYER * NL;
    constexpr int J1 = NWT, J2 = J1 + R / 8, J3 = J2 + 128, J4 = J3 + 1024, J5 = J4 + 1024, J6 = J5 + 8192, J7 = J6 + 8192, J8 = J7 + 1024, J9 = J8 + 1024, J10 = J9 + 4096;
    for (int j = bid; j < J10; j += G) {
      if (j < J1) wt_job(smem, p, j);
      else if (j < J2) rowprep_job(p, j - J1, false);
      else if (j < J3) rowprep_job(p, j - J2, true);
      else if (j < J4) conv_job(p.in[3], p.SKA, j - J3, 512 * 256, 576 * 256);
      else if (j < J5) conv_job(p.in[4], p.SVA, j - J4, 512 * 256, 576 * 256);
      else if (j < J6) conv_job(p.in[5], p.SKB, j - J5, 2048 * 512, 2112 * 512);
      else if (j < J7) conv_job(p.in[6], p.SVB, j - J6, 2048 * 512, 2112 * 512);
      else if (j < J8) conv_job(p.in[9], p.SKM, j - J7, 256 * 512, 256 * 512);
      else if (j < J9) conv_job(p.in[10], p.SVM, j - J8, 256 * 512, 256 * 512);
      else conv_job(p.in[7], p.CCKVb, j - J9, 2048 * 256, 2048 * 256);
    }
    return;
  }
  if (ph == 1) {
    for (int j = bid; j < 128 + 1024; j += G) {
      if (j < 128) { const int l = j >> 5, m = (j >> 2) & 7, n = j & 3;
        gemm_unit<4>(smem, p.MEMb, 1024, p.Wmkv + (size_t)l * 1024 * 1024, 1024, 1024, m * 128, n * 256, EpiMemKV{&p, l, 0});
      } else { const int q = j - 128, l = q >> 8, m = (q >> 1) & 127, n = q & 1;
        gemm_unit<4>(smem, p.CCKVb + (size_t)l * 16384 * 256, 256, p.Wukvu + (size_t)l * 512 * 256, 256, 256, m * 128, n * 256, EpiKv{&p, l, 0, 1}); }
    }
    return;
  }
  const int l = (ph - 2) / 10, s = (ph - 2) % 10;
#ifdef ONLY_S
  if (s != ONLY_S) return;
#endif
  if (s == 0 || s == 8) {
    const bf16_t* W = p.Wgu1 + (size_t)((s == 0 ? 0 : NL) + l) * 5632 * 1024;
    for (int it = 0;; ++it) { int m, n; if (!gemm_job(it, 66, 22, m, n)) break;
      gemm_unit<8>(smem, p.Xb, 1024, W, 1024, 1024, m * 256, n * 256, EpiFfnUp{p.ss, p.H, 0}); }
    for (int it = 0;; ++it) { int m, n, hf; if (!gemm_tail(it, 66, 22, m, n, hf)) break;
      gemm_unit<4>(smem, p.Xb, 1024, W, 1024, 1024, m * 256 + 128 * hf, n * 256, EpiFfnUp{p.ss, p.H, 0}); }
  } else if (s == 1 || s == 9) {
    const bf16_t* W = p.Wd1 + (size_t)((s == 1 ? 0 : NL) + l) * 1024 * 2816;
    for (int j = bid; j < 256; j += G) gemm_unit<8>(smem, p.H, DFF, W, DFF, DFF, (j >> 2) * 256, (j & 3) * 256, EpiResid{p.out, p.Xb, p.ss, 0, 0.5f});
    for (int t = bid; t < 32; t += G) gemm_unit<2>(smem, p.H, DFF, W, DFF, DFF, RP + 64 * (t >> 2), (t & 3) * 256, EpiResid{p.out, p.Xb, p.ss, 0, 0.5f});
  } else if (s == 2) {
    const bf16_t* W = p.Win + (size_t)l * 3072 * 1024;
    for (int it = 0;; ++it) { int m, n; if (!gemm_job(it, 132, 12, m, n)) break;
      gemm_unit<4>(smem, p.Xb, 1024, W, 1024, 1024, m * 128, n * 256, EpiProj{&p, l, 0}); }
    for (int it = 0;; ++it) { int m, n, hf; if (!gemm_tail(it, 132, 12, m, n, hf)) break;
      gemm_unit<2>(smem, p.Xb, 1024, W, 1024, 1024, m * 128 + 64 * hf, n * 256, EpiProj{&p, l, 0}); }
  } else if (s == 3) {
    for (int j = bid; j < 132 * 4; j += G) { const int m = j >> 2, n = (j >> 1) & 1;
      if (j & 1) gemm_unit<4>(smem, p.CKVraw, 256, p.Wukv + (size_t)l * 512 * 256, 256, 256, m * 128, n * 256, EpiKv{&p, l, 0, 0});
      else gemm_unit<4>(smem, p.CQraw, 384, p.Wuq + (size_t)l * 512 * 384, 384, 384, m * 128, n * 256, EpiQc{&p, l, 0}); }
  } else if (s == 4) {
    constexpr int NJ = 4 * NAJ;
    int* sj = (int*)(smem + 72000);
    for (;;) {
      __syncthreads();
      if (threadIdx.x == 0) *sj = (int)__hip_atomic_fetch_add(p.actr + l, 1u, __ATOMIC_RELAXED, __HIP_MEMORY_SCOPE_AGENT);
      __syncthreads();
      const int j = *sj; if (j >= NJ) break;
      const int grp = j / NAJ, q = j % NAJ; const int kind = grp == 0 ? 1 : (grp == 1 ? 3 : (grp == 2 ? 2 : 0));
      const bool sm = q >= 256;
      attn_job(smem, p, l, kind, sm, sm ? ((q - 256) >> 2) : ((q >> 2) & 3), q & 3, sm ? 0 : 15 - (q >> 4), q); }
  } else if (s == 5) {
    const bf16_t* W = p.Wout + (size_t)l * 1024 * 1024;
    for (int j = bid; j < 256; j += G) gemm_unit<8>(smem, p.OMIX, 1024, W, 1024, 1024, (j >> 2) * 256, (j & 3) * 256, EpiResid{p.out, p.Xb, p.ss, 0, 1.0f});
    for (int t = bid; t < 32; t += G) gemm_unit<2>(smem, p.OMIX, 1024, W, 1024, 1024, RP + 64 * (t >> 2), (t & 3) * 256, EpiResid{p.out, p.Xb, p.ss, 0, 1.0f});
  } else if (s == 6) {
    const bf16_t* W = p.Wmq + (size_t)l * 512 * 1024;
    for (int j = bid; j < 128 + 16; j += G) {
      if (j < 128) { const int m = j >> 1, n = j & 1, b = m >> 4;
        gemm_unit<4>(smem, p.Xb, 1024, W, 1024, 1024, m * 256, n * 256, EpiMemQ{&p, l, 0});
        gemm_unit<4>(smem, p.Xb, 1024, W, 1024, 1024, m * 256 + 128, n * 256, EpiMemQ{&p, l, 0});
        __syncthreads();
        for (int u = 0; u < 2; ++u) mem_attn(smem, p, l, m * 256, 256, 2 * n + u, p.MK + (size_t)(l * 4 + b) * 256 * 512, p.MV + (size_t)(l * 4 + b) * 256 * 512);
      } else { const int sb = (j - 128) >> 1, n = j & 1;
        gemm_unit<2>(smem, p.Xb, 1024, W, 1024, 1024, RP + 64 * sb, n * 256, EpiMemQ{&p, l, 0});
        __syncthreads();
        for (int u = 0; u < 2; ++u) mem_attn(smem, p, l, RP + 64 * sb, 64, 2 * n + u, p.SKM + (size_t)(l * 8 + sb) * 256 * 512, p.SVM + (size_t)(l * 8 + sb) * 256 * 512); }
    }
  } else if (s == 7) {
    const bf16_t* W = p.Wmo + (size_t)l * 1024 * 512;
    for (int j = bid; j < 256; j += G) gemm_unit<8>(smem, p.OM, 512, W, 512, 512, (j >> 2) * 256, (j & 3) * 256, EpiResid{p.out, p.Xb, p.ss, 0, 1.0f});
    for (int t = bid; t < 32; t += G) gemm_unit<2>(smem, p.OM, 512, W, 512, 512, RP + 64 * (t >> 2), (t & 3) * 256, EpiResid{p.out, p.Xb, p.ss, 0, 1.0f});
  }
}

__global__ void __launch_bounds__(NTHR, 2) mega(Params p, int ph_lo, int ph_hi) {
  __shared__ __attribute__((aligned(16))) char smem[LDS_BYTES];
  __shared__ uint4 xb_words;
  if (ph_hi < 0) { cg::this_grid().sync(); }
  if (threadIdx.x == 0) xb_words = make_uint4(0u, 0u, 0u, 0u);
  __syncthreads();
  XcdBarrier xb = xcd_barrier_post(p.bar, (volatile LAS unsigned*)&xb_words);
  for (int ph = ph_lo; ph < ph_hi; ++ph) {
    run_phase<-1>(p, smem, ph);
#if REP_UP
    if (ph >= 2 && ((ph - 2) % 10 == 0 || (ph - 2) % 10 == 8)) { xcd_barrier(xb); run_phase<-1>(p, smem, ph); }
#endif
#if REP_ATT
    if (ph >= 2 && ((ph - 2) % 10 == 4)) { xcd_barrier(xb); run_phase<-1>(p, smem, ph); }
#endif
    if (ph + 1 < ph_hi) xcd_barrier(xb);
#if REP_SYNC
    if (ph + 1 < ph_hi) xcd_barrier(xb);
#endif
  }
}

#ifndef MK_MULTI
#define MK_MULTI 0
#endif

extern "C" void kernel_launch(void* const* d_in, const int* in_sizes, int n_in, void* d_out, int out_size, void* d_ws, size_t ws_size, hipStream_t stream) {
  Params p; memset(&p, 0, sizeof(p));
  for (int i = 0; i < 43; ++i) p.in[i] = (const float*)d_in[i];
  p.out = (float*)d_out;
  long off = 0;
  auto take = [&](long n) { long o = off; off += n; return o; };
  take((long)RP * DM); p.o_ys = take(512L * DM);
  p.o_pak = take(4L * 4 * 512 * 256); p.o_pav = take(4L * 4 * 512 * 256);
  p.o_pbk = take(4L * RP * 512); p.o_pbv = take(4L * RP * 512);
  p.o_pckv = take(4L * RP * 256); p.o_pckpe = take(4L * RP * 32);
  p.o_pmk = take(4L * 4 * 256 * 512); p.o_pmv = take(4L * 4 * 256 * 512);
  p.o_sak = take(4L * 512 * 256); p.o_sav = take(4L * 512 * 256);
  p.o_sbk = take(4L * 512 * 512); p.o_sbv = take(4L * 512 * 512);
  p.o_sckv = take(4L * 512 * 256); p.o_sckpe = take(4L * 512 * 32);
  char* ws = (char*)d_ws; size_t wo = 0;
  auto alloc = [&](size_t bytes) { char* r = ws + wo; wo += (bytes + 255) & ~(size_t)255; return r; };
  p.Wgu1 = (bf16_t*)alloc((size_t)2 * NL * 5632 * 1024 * 2); p.Wd1 = (bf16_t*)alloc((size_t)2 * NL * 1024 * 2816 * 2);
  p.Wgu2 = p.Wgu1 + (size_t)NL * 5632 * 1024; p.Wd2 = p.Wd1 + (size_t)NL * 1024 * 2816;
  p.Win = (bf16_t*)alloc((size_t)NL * 3072 * 1024 * 2); p.Wuq = (bf16_t*)alloc((size_t)NL * 512 * 384 * 2);
  p.Wukv = (bf16_t*)alloc((size_t)NL * 512 * 256 * 2); p.Wukvu = (bf16_t*)alloc((size_t)NL * 512 * 256 * 2);
  p.Wout = (bf16_t*)alloc((size_t)NL * 1024 * 1024 * 2); p.Wmq = (bf16_t*)alloc((size_t)NL * 512 * 1024 * 2);
  p.Wmkv = (bf16_t*)alloc((size_t)NL * 1024 * 1024 * 2); p.Wmo = (bf16_t*)alloc((size_t)NL * 1024 * 512 * 2);
  p.Xb = (bf16_t*)alloc((size_t)R * 1024 * 2);
  const size_t ubase = wo;
  p.OMIX = (bf16_t*)alloc((size_t)R * 1024 * 2); p.QA = (bf16_t*)alloc((size_t)R * 256 * 2); p.QB = (bf16_t*)alloc((size_t)R * 512 * 2);
  p.QC = (bf16_t*)alloc((size_t)R * 384 * 2); p.CQraw = (bf16_t*)alloc((size_t)R * 384 * 2); p.CKVraw = (bf16_t*)alloc((size_t)R * 256 * 2);
  p.PKA = (bf16_t*)alloc((size_t)RP * 256 * 2); p.PVA = (bf16_t*)alloc((size_t)RP * 256 * 2);
  p.PKB = (bf16_t*)alloc((size_t)RP * 512 * 2); p.PVB = (bf16_t*)alloc((size_t)RP * 512 * 2);
  p.PKC = (bf16_t*)alloc((size_t)RP * 384 * 2); p.PVC = (bf16_t*)alloc((size_t)RP * 256 * 2);
  p.H = (bf16_t*)(ws + ubase);
  if (wo - ubase < (size_t)R * DFF * 2) wo = ubase + (size_t)R * DFF * 2;
  p.OM = (bf16_t*)alloc((size_t)R * 512 * 2); p.QM = (bf16_t*)alloc((size_t)R * 512 * 2);
  p.SKA = (bf16_t*)alloc((size_t)NL * 8 * 576 * 256 * 2); p.SVA = (bf16_t*)alloc((size_t)NL * 8 * 576 * 256 * 2);
  p.SKB = (bf16_t*)alloc((size_t)NL * 8 * 2112 * 512 * 2); p.SVB = (bf16_t*)alloc((size_t)NL * 8 * 2112 * 512 * 2);
  p.SKC = (bf16_t*)alloc((size_t)NL * 8 * 2112 * 384 * 2); p.SVC = (bf16_t*)alloc((size_t)NL * 8 * 2112 * 256 * 2);
  p.SKM = (bf16_t*)alloc((size_t)NL * 8 * 256 * 512 * 2); p.SVM = (bf16_t*)alloc((size_t)NL * 8 * 256 * 512 * 2);
  p.MK = (bf16_t*)alloc((size_t)NL * 4 * 256 * 512 * 2); p.MV = (bf16_t*)alloc((size_t)NL * 4 * 256 * 512 * 2);
  p.MEMb = (bf16_t*)alloc((size_t)1024 * 1024 * 2); p.CCKVb = (bf16_t*)alloc((size_t)NL * 8 * 2048 * 256 * 2);
  p.ss = (float*)alloc((size_t)16 * R * 4); p.memss = (float*)alloc((size_t)16 * 1024 * 4);
  p.cqss = (float*)alloc((size_t)6 * R * 4); p.ckvss = (float*)alloc((size_t)4 * R * 4); p.KPE = (float*)alloc((size_t)R * 32 * 4);
  static int grid_blocks = 0;
  if (!grid_blocks) { int dev = 0, cus = 0, per_cu = 0; hipGetDevice(&dev); hipDeviceGetAttribute(&cus, hipDeviceAttributeMultiprocessorCount, dev);
    hipOccupancyMaxActiveBlocksPerMultiprocessor(&per_cu, mega, NTHR, 0); per_cu = 1; grid_blocks = cus * per_cu; }
  p.OB0 = (float*)alloc((size_t)R * 512 * 4);
  p.bar = (unsigned*)alloc((size_t)(XCD_BAR_WORDS + 4 * NAJ + 64) * 4); p.bflag = p.bar + XCD_BAR_WORDS; p.actr = p.bflag + 4 * NAJ;
  if (wo > ws_size) { fprintf(stderr, "workspace too small: need %zu have %zu\n", wo, ws_size); return; }
  for (int l = 0; l < 4; ++l) p.lam_init[l] = (float)(0.8 - 0.6 * exp(-0.3 * (double)l));
  (void)hipMemsetAsync(p.bar, 0, (size_t)(XCD_BAR_WORDS + 4 * NAJ + 64) * 4, stream);
#if MK_MULTI
  for (int ph = 0; ph < NPH; ++ph) { hipLaunchKernelGGL(mega, dim3(grid_blocks), dim3(NTHR), 0, stream, p, ph, ph + 1); }
#else
  int lo = 0, hi = NPH; void* args[] = {&p, &lo, &hi};
  hipError_t e = hipLaunchCooperativeKernel((void*)mega, dim3(grid_blocks), dim3(NTHR), args, 0, stream);
  if (e != hipSuccess) fprintf(stderr, "cooperative launch failed: %s (grid %d)\n", hipGetErrorString(e), grid_blocks);
#endif
}
```

```cpp
#include <hip/hip_runtime.h>
#include <hip/hip_cooperative_groups.h>
#include <cstdint>
#include <cstring>
#include <cstdio>
#include <cmath>
namespace cg = cooperative_groups;
#ifndef REP_UP
#define REP_UP 0
#endif
#ifndef REP_SYNC
#define REP_SYNC 0
#endif
#ifndef REP_ATT
#define REP_ATT 0
#endif

typedef unsigned short bf16_t;
typedef short bf16x8 __attribute__((ext_vector_type(8)));
typedef short s16x4 __attribute__((ext_vector_type(4)));
typedef float f32x16 __attribute__((ext_vector_type(16)));
typedef float f32x4 __attribute__((ext_vector_type(4)));
typedef unsigned u32x4 __attribute__((ext_vector_type(4)));
typedef unsigned u32x2 __attribute__((ext_vector_type(2)));

#define DI __device__ __forceinline__
#define MFMA32(a, b, c) __builtin_amdgcn_mfma_f32_32x32x16_bf16((a), (b), (c), 0, 0, 0)

constexpr int R = 16896, RP = 16384, DM = 1024, DFF = 2816, NL = 4;
constexpr int LDS_BYTES = 128 * 272 * 4;
constexpr int NTHR = 512;
constexpr int NAJ = 288;
constexpr float LOG2E = 1.4426950408889634f;
constexpr float EPS = 1e-6f;
constexpr int NPH = 2 + 10 * NL;
#ifndef MK_MINW
#define MK_MINW 2
#endif

DI unsigned pk2(float lo, float hi) { unsigned r; asm("v_cvt_pk_bf16_f32 %0, %1, %2" : "=v"(r) : "v"(lo), "v"(hi)); return r; }
DI float b2f(bf16_t b) { return __uint_as_float((unsigned)b << 16); }
DI int crow(int r, int hi) { return (r & 3) + 8 * (r >> 2) + 4 * hi; }
DI int ltid() { int t = threadIdx.x; asm volatile("" : "+v"(t)); return t; }


#define XB_TMO      128
#define XB_XCNT(j)  (256  + 64 * (j))
#define XB_XSUB(j)  (1280 + 64 * (j))
#define XB_XGEN(j)  (2304 + 64 * (j))
#define XB_TOP      3328
#define XB_TOPGEN   3392
#define XCD_BAR_WORDS 3456
#define XB_SPIN_CAP (1u << 18)
#define LAS __attribute__((address_space(3)))
DI unsigned xb_ld(unsigned* p)              { return __hip_atomic_load(p, __ATOMIC_RELAXED, __HIP_MEMORY_SCOPE_AGENT); }
DI unsigned xb_add(unsigned* p, unsigned v) { return __hip_atomic_fetch_add(p, v, __ATOMIC_RELAXED, __HIP_MEMORY_SCOPE_AGENT); }
DI unsigned xb_xcc_id() { return (unsigned)__builtin_amdgcn_s_getreg((3 << 11) | 20) & 0xFu; }
#define XB_SPIN(cond, bar) do { unsigned _sp = 0; while (cond) { __builtin_amdgcn_s_sleep(1); \
    if ((++_sp & 255u) == 0u) { if (xb_ld(&(bar)[XB_TMO])) break; if (_sp > XB_SPIN_CAP) { atomicAdd(&(bar)[XB_TMO], 1u); break; } } } } while (0)
struct XcdBarrier { unsigned* bar; unsigned x; volatile LAS unsigned* st; };
DI XcdBarrier xcd_barrier_post(unsigned* bar, volatile LAS unsigned* st) {
  XcdBarrier b; b.bar = bar; b.x = xb_xcc_id(); b.st = st;
  if (threadIdx.x == 0) (void)xb_add(&bar[XB_XCNT(b.x)], 1u);
  return b; }
DI void xcd_barrier_complete(unsigned* bar, unsigned x, unsigned& nloc, unsigned& nx) {
  const unsigned G = gridDim.x * gridDim.y * gridDim.z;
  unsigned sum, cnt, mine, sp = 0u;
  for (;;) {
    sum = 0u; cnt = 0u; mine = 0u;
#pragma unroll
    for (unsigned j = 0; j < 16; ++j) { const unsigned c = xb_ld(&bar[XB_XCNT(j)]); sum += c; cnt += (c > 0u) ? 1u : 0u; mine = (j == x) ? c : mine; }
    if (sum == G) break;
    __builtin_amdgcn_s_sleep(1);
    if ((++sp & 255u) == 0u) { if (xb_ld(&bar[XB_TMO])) break; if (sp > XB_SPIN_CAP) { atomicAdd(&bar[XB_TMO], 1u); break; } }
  }
  nloc = mine > 0u ? mine : 1u; nx = cnt > 0u ? cnt : 1u; }
DI void xcd_barrier(const XcdBarrier& b) {
  asm volatile("s_waitcnt vmcnt(0)" ::: "memory");
  __syncthreads();
  if (threadIdx.x == 0) {
    unsigned* bar = b.bar;
    __builtin_amdgcn_s_waitcnt(0);
    unsigned nloc = b.st[0], nx = b.st[1];
    if (nloc == 0u) { xcd_barrier_complete(bar, b.x, nloc, nx); b.st[0] = nloc; b.st[1] = nx; }
    const unsigned old = xb_add(&bar[XB_XSUB(b.x)], 1u);
    const unsigned gen = old / nloc;
    if (old + 1u == (gen + 1u) * nloc) {
      __builtin_amdgcn_fence(__ATOMIC_RELEASE, "agent");
      asm volatile("s_waitcnt vmcnt(0)" ::: "memory");
      const unsigned og = xb_add(&bar[XB_TOP], 1u);
      const unsigned tg = og / nx;
      if (og + 1u == (tg + 1u) * nx) xb_add(&bar[XB_TOPGEN], 1u);
      else XB_SPIN(xb_ld(&bar[XB_TOPGEN]) == tg, bar);
      __builtin_amdgcn_fence(__ATOMIC_ACQUIRE, "agent");
      xb_add(&bar[XB_XGEN(b.x)], 1u);
      asm volatile("s_waitcnt vmcnt(0)" ::: "memory");
    } else {
      XB_SPIN(xb_ld(&bar[XB_XGEN(b.x)]) == gen, bar);
      __builtin_amdgcn_fence(__ATOMIC_ACQUIRE, "agent");
      asm volatile("s_waitcnt vmcnt(0)" ::: "memory");
    }
  }
  __syncthreads();
}

struct Params {
  const float* in[43];
  float* out;
  long o_ys, o_pak, o_pav, o_pbk, o_pbv, o_pckv, o_pckpe, o_pmk, o_pmv, o_sak, o_sav, o_sbk, o_sbv, o_sckv, o_sckpe;
  bf16_t *Wgu1, *Wd1, *Win, *Wuq, *Wukv, *Wukvu, *Wout, *Wmq, *Wmkv, *Wmo, *Wgu2, *Wd2;
  bf16_t *Xb, *H, *OMIX, *OM, *QA, *QB, *QC, *QM, *CQraw, *CKVraw;
  bf16_t *PKA, *PVA, *PKB, *PVB, *PKC, *PVC;
  bf16_t *SKA, *SVA, *SKB, *SVB, *SKC, *SVC, *SKM, *SVM;
  bf16_t *MK, *MV, *MEMb, *CCKVb;
  float *ss, *memss, *cqss, *ckvss, *KPE, *OB0;
  unsigned* bar; unsigned* bflag; unsigned* actr;
  float lam_init[4];
};

DI float sumsq64(const float (&v)[64]) { float s = 0.f;
#pragma unroll
  for (int i = 0; i < 64; ++i) s += v[i] * v[i];
  return s; }
DI void store_bf16_64(bf16_t* dst, const float (&v)[64]) {
#pragma unroll
  for (int c = 0; c < 8; ++c) { u32x4 w; w.x = pk2(v[8 * c], v[8 * c + 1]); w.y = pk2(v[8 * c + 2], v[8 * c + 3]); w.z = pk2(v[8 * c + 4], v[8 * c + 5]); w.w = pk2(v[8 * c + 6], v[8 * c + 7]); *(u32x4*)(dst + 8 * c) = w; } }
DI void store_bf16_32(bf16_t* dst, const float (&v)[64]) {
#pragma unroll
  for (int c = 0; c < 4; ++c) { u32x4 w; w.x = pk2(v[8 * c], v[8 * c + 1]); w.y = pk2(v[8 * c + 2], v[8 * c + 3]); w.z = pk2(v[8 * c + 4], v[8 * c + 5]); w.w = pk2(v[8 * c + 6], v[8 * c + 7]); *(u32x4*)(dst + 8 * c) = w; } }
DI void store_f32_64(float* dst, const float (&v)[64]) {
#pragma unroll
  for (int c = 0; c < 16; ++c) { f32x4 w = {v[4 * c], v[4 * c + 1], v[4 * c + 2], v[4 * c + 3]}; *(f32x4*)(dst + 4 * c) = w; } }
DI void mulgain64(float (&v)[64], const float* g, float sc) {
#pragma unroll
  for (int c = 0; c < 16; ++c) { f32x4 w = *(const f32x4*)(g + 4 * c); v[4 * c] *= w.x * sc; v[4 * c + 1] *= w.y * sc; v[4 * c + 2] *= w.z * sc; v[4 * c + 3] *= w.w * sc; } }
DI void scale64(float (&v)[64], float sc) {
#pragma unroll
  for (int i = 0; i < 64; ++i) v[i] *= sc; }
DI float rstd_from(const float* ssp, int np, int stride, int row, float invn) { float s = 0.f; for (int q = 0; q < np; ++q) s += ssp[(size_t)q * stride + row]; return rsqrtf(s * invn + EPS); }
DI void rope32(float (&v)[64], int pos) {
  const float fp = (float)pos;
#pragma unroll
  for (int i = 0; i < 16; ++i) {
    const float inv = ((i & 3) == 0 ? 1.f : (i & 3) == 1 ? 0.5623413251903491f : (i & 3) == 2 ? 0.31622776601683794f : 0.17782794100389228f)
                    * ((i >> 2) == 0 ? 1.f : (i >> 2) == 1 ? 0.1f : (i >> 2) == 2 ? 0.01f : 0.001f);
    const float ang = fp * inv;
    float rev = ang * 0.15915494309189535f; rev -= floorf(rev);
    const float c = __builtin_amdgcn_cosf(rev), s = __builtin_amdgcn_sinf(rev);
    const float x1 = v[i], x2 = v[16 + i]; v[i] = x1 * c - x2 * s; v[16 + i] = x1 * s + x2 * c; } }

typedef int i32x4 __attribute__((ext_vector_type(4)));
DI int lds_byte2(int r, int c) { const int st = (r >> 4) * 2 + (c >> 5), ob = (r & 15) * 64 + (c & 31) * 2; return st * 1024 + (ob ^ (((ob >> 9) & 1) << 5)); }
DI void stage_rc2(int b, int& Rr, int& Cc) { const int st = b >> 10, sb = b & 1023, swz = sb ^ (((sb >> 9) & 1) << 5); Rr = (st >> 1) * 16 + swz / 64; Cc = (st & 1) * 32 + (swz % 64) / 2; }
constexpr int G_TILE_B = 256 * 64 * 2, G_STAGE_B = 2 * G_TILE_B;

template <int MT, class Epi>
DI void gemm_unit(char* smem, const bf16_t* __restrict__ A, int lda, const bf16_t* __restrict__ Bt, int ldb, int K, int row0, int col0, Epi epi) {
  const int tid = ltid(), wid = tid >> 6, lane = tid & 63, wr = wid >> 2, wc = wid & 3, fr = lane & 15, fq = lane >> 4;
  constexpr int GLA = MT / 2, GLB = 4;
  const bf16_t* Ab = A + (size_t)row0 * lda;
  const bf16_t* Bb = Bt + (size_t)col0 * ldb;
  int aoff[GLA], boff[GLB];
#pragma unroll
  for (int i = 0; i < GLA; ++i) { int rr, cc; stage_rc2(wid * 1024 + i * 8192 + lane * 16, rr, cc); aoff[i] = rr * lda + cc; }
#pragma unroll
  for (int i = 0; i < GLB; ++i) { int rr, cc; stage_rc2(wid * 1024 + i * 8192 + lane * 16, rr, cc); boff[i] = rr * ldb + cc; }
  f32x4 acc[MT][4];
#pragma unroll
  for (int m = 0; m < MT; ++m)
#pragma unroll
    for (int n = 0; n < 4; ++n) acc[m][n] = (f32x4){0.f, 0.f, 0.f, 0.f};
  i32x4 sa[GLA], sb[GLB];
#define U_SA(b) (smem + (b) * G_STAGE_B)
#define U_SB(b) (smem + (b) * G_STAGE_B + G_TILE_B)
#define U_ISSUE(kt) do { _Pragma("unroll") for (int i = 0; i < GLA; ++i) sa[i] = *(const i32x4*)(Ab + aoff[i] + (kt) * 64); \
    _Pragma("unroll") for (int i = 0; i < GLB; ++i) sb[i] = *(const i32x4*)(Bb + boff[i] + (kt) * 64); __builtin_amdgcn_sched_barrier(0); } while (0)
#define U_WRITE(buf) do { _Pragma("unroll") for (int i = 0; i < GLA; ++i) *(i32x4*)(U_SA(buf) + wid * 1024 + i * 8192 + lane * 16) = sa[i]; \
    _Pragma("unroll") for (int i = 0; i < GLB; ++i) *(i32x4*)(U_SB(buf) + wid * 1024 + i * 8192 + lane * 16) = sb[i]; } while (0)
#define U_RDA(m, buf, ks) (*(const bf16x8*)(U_SA(buf) + lds_byte2(wr * 16 * MT + (m) * 16 + fr, (ks) * 32 + fq * 8)))
#define U_MM(m, AR, BF) do { _Pragma("unroll") for (int n = 0; n < 4; ++n) acc[m][n] = __builtin_amdgcn_mfma_f32_16x16x32_bf16(BF[n], AR, acc[m][n], 0, 0, 0); } while (0)
#define U_SBAR __builtin_amdgcn_sched_barrier(0)
#define U_RDB(BF, buf, ks) do { _Pragma("unroll") for (int n = 0; n < 4; ++n) BF[n] = *(const bf16x8*)(U_SB(buf) + lds_byte2(wc * 64 + n * 16 + fr, (ks) * 32 + fq * 8)); } while (0)
#define U_KTILE(buf) do { bf16x8 Bf[4], Bg[4], A0, A1; \
    U_RDB(Bf, buf, 0); A0 = U_RDA(0, buf, 0); \
    _Pragma("unroll") for (int m = 0; m < MT; m += 2) { \
      A1 = U_RDA(m + 1, buf, 0); U_SBAR; U_MM(m, A0, Bf); U_SBAR; \
      if (m + 2 < MT) { A0 = U_RDA(m + 2, buf, 0); } else { U_RDB(Bg, buf, 1); A0 = U_RDA(0, buf, 1); } U_SBAR; U_MM(m + 1, A1, Bf); U_SBAR; } \
    _Pragma("unroll") for (int m = 0; m < MT; m += 2) { \
      A1 = U_RDA(m + 1, buf, 1); U_SBAR; U_MM(m, A0, Bg); U_SBAR; \
      if (m + 2 < MT) A0 = U_RDA(m + 2, buf, 1); U_SBAR; U_MM(m + 1, A1, Bg); U_SBAR; } } while (0)
  const int nt = K >> 6;
  float* rtab = (float*)(smem + 2 * G_STAGE_B);
  if constexpr (Epi::NEED_RSTD) { if (tid < 32 * MT) rtab[tid] = rstd_from(epi.ss, 16, R, row0 + tid, 1.f / 1024.f); }
  U_ISSUE(0); U_WRITE(0); U_ISSUE(1); __syncthreads();
#pragma unroll 1
  for (int t = 0; t < nt; ++t) { const int cur = t & 1;
    if (t + 1 < nt) U_WRITE(cur ^ 1);
    if (t + 2 < nt) U_ISSUE(t + 2);
    U_KTILE(cur);
    __syncthreads(); }
#undef U_SA
#undef U_SB
#undef U_ISSUE
#undef U_WRITE
#undef U_KTILE
#undef U_RDB
#undef U_RDA
#undef U_MM
#undef U_SBAR
  if constexpr (Epi::DIRECT) {
    epi.template direct<MT>(acc, row0, wr * 16 * MT, col0 + wc * 64, fr, fq, rtab);
    __syncthreads();
  } else {
    static_assert(MT <= 4, "LDS epilogue: the whole unit (<= 128 rows x 256 cols f32) is parked in LDS at once");
    float* Ct = (float*)smem;
#pragma unroll
    for (int m = 0; m < MT; ++m)
#pragma unroll
      for (int n = 0; n < 4; ++n) *(f32x4*)(Ct + (wr * 16 * MT + m * 16 + fr) * 272 + wc * 68 + n * 16 + fq * 4) = acc[m][n];
    __syncthreads();
    if (tid < 128 * MT) {
      const int row = tid >> 2, piece = tid & 3; float v[64];
      const float* src = Ct + row * 272 + piece * 68;
#pragma unroll
      for (int c = 0; c < 16; ++c) { const f32x4 t4 = *(const f32x4*)(src + 4 * c); v[4 * c] = t4.x; v[4 * c + 1] = t4.y; v[4 * c + 2] = t4.z; v[4 * c + 3] = t4.w; }
      epi.nt = (col0 >> 7) + (piece >> 1);
      epi(row0 + row, piece & 1, v);
    }
    __syncthreads();
  }
}

struct EpiFfnUp { const float* ss; bf16_t* H; int nt;
  static constexpr bool DIRECT = true, NEED_RSTD = true;
  template <int MT> DI void direct(const f32x4 (&acc)[MT][4], int row0, int lrow, int cbase, int fr, int fq, const float* rtab) const {
#pragma unroll
    for (int m = 0; m < MT; ++m) { const float rs = rtab[lrow + m * 16 + fr]; bf16_t* dst = H + (size_t)(row0 + lrow + m * 16 + fr) * DFF + (cbase >> 1) + fq * 4;
#pragma unroll
      for (int q = 0; q < 2; ++q) { float h[4];
#pragma unroll
        for (int j = 0; j < 4; ++j) { const float g = acc[m][2 * q][j] * rs, u = acc[m][2 * q + 1][j] * rs; h[j] = g * __builtin_amdgcn_rcpf(1.f + __expf(-g)) * u; }
        u32x2 w; w.x = pk2(h[0], h[1]); w.y = pk2(h[2], h[3]); *(u32x2*)(dst + q * 16) = w; } }
  }
  DI void operator()(int, int, float (&)[64]) const {} };

struct EpiResid { float* X; bf16_t* Xb; float* ss; int nt; float scale;
  static constexpr bool DIRECT = true, NEED_RSTD = false;
  template <int MT> DI void direct(const f32x4 (&acc)[MT][4], int row0, int lrow, int cbase, int fr, int fq, const float*) const {
#pragma unroll
    for (int m = 0; m < MT; ++m) { const int row = row0 + lrow + m * 16 + fr; float sq = 0.f;
      float* xp = X + (size_t)row * DM + cbase + fq * 4; bf16_t* bp = Xb + (size_t)row * DM + cbase + fq * 4;
#pragma unroll
      for (int n = 0; n < 4; ++n) { f32x4 x = *(const f32x4*)(xp + n * 16);
        x.x += scale * acc[m][n][0]; x.y += scale * acc[m][n][1]; x.z += scale * acc[m][n][2]; x.w += scale * acc[m][n][3];
        *(f32x4*)(xp + n * 16) = x; u32x2 w; w.x = pk2(x.x, x.y); w.y = pk2(x.z, x.w); *(u32x2*)(bp + n * 16) = w;
        sq += x.x * x.x + x.y * x.y + x.z * x.z + x.w * x.w; }
      sq += __shfl_xor(sq, 16); sq += __shfl_xor(sq, 32);
      if (fq == 0) ss[(size_t)(cbase >> 6) * R + row] = sq;
      if (m & 1) __builtin_amdgcn_sched_barrier(0); }
  }
  DI void operator()(int, int, float (&)[64]) const {} };

struct EpiProj { const Params* pp; int l; int nt;
  static constexpr bool DIRECT = false, NEED_RSTD = false;
  DI void operator()(int row, int half, float (&v)[64]) const {
    const Params& p = *pp;
    const bool samp = row >= RP; const int sr = row - RP; const int b = samp ? (sr >> 6) : (row >> 12); const int t = samp ? (sr & 63) : (row & 4095);
    scale64(v, rstd_from(p.ss, 16, R, row, 1.f / 1024.f));
    if (nt < 2) { const int head = 2 * nt + half; const float r2 = rsqrtf(sumsq64(v) * (1.f / 64.f) + EPS);
      mulgain64(v, p.in[17] + l * 64, r2 * 0.125f * LOG2E); store_bf16_64(p.QA + (size_t)row * 256 + head * 64, v);
    } else if (nt < 6) { const bool isk = nt < 4; const int head = 2 * (nt - (isk ? 2 : 4)) + half;
      if (isk) { const float r2 = rsqrtf(sumsq64(v) * (1.f / 64.f) + EPS); mulgain64(v, p.in[18] + l * 64, r2); }
      bf16_t* kb = isk ? (samp ? p.SKA : p.PKA) : (samp ? p.SVA : p.PVA);
      const size_t krow = samp ? ((size_t)(l * 8 + b) * 576 + 512 + t) : (size_t)row;
      store_bf16_64(kb + krow * 256 + head * 64, v);
      if (samp) store_f32_64(p.out + (isk ? p.o_sak : p.o_sav) + ((size_t)(l * 8 + b) * 64 + t) * 256 + head * 64, v);
      else if (t >= 3584) store_f32_64(p.out + (isk ? p.o_pak : p.o_pav) + ((size_t)(l * 4 + b) * 512 + (t - 3584)) * 256 + head * 64, v);
    } else if (nt < 10) { const int g = 2 * (nt - 6) + half; const float r2 = rsqrtf(sumsq64(v) * (1.f / 64.f) + EPS);
      mulgain64(v, p.in[20] + l * 64, r2 * 0.125f * LOG2E); store_bf16_64(p.QB + (size_t)row * 512 + g * 64, v);
    } else if (nt < 18) { const bool isk = nt < 14; const int col = isk ? (128 * (nt - 10) + 64 * half) : (128 * (nt - 14) + 64 * half);
      if (isk) { const float r2 = rsqrtf(sumsq64(v) * (1.f / 64.f) + EPS); mulgain64(v, p.in[21] + l * 64, r2); }
      bf16_t* kb = isk ? (samp ? p.SKB : p.PKB) : (samp ? p.SVB : p.PVB);
      const size_t krow = samp ? ((size_t)(l * 8 + b) * 2112 + 2048 + t) : (size_t)row;
      store_bf16_64(kb + krow * 512 + col, v);
      if (samp) store_f32_64(p.out + (isk ? p.o_sbk : p.o_sbv) + ((size_t)l * 512 + sr) * 512 + col, v);
      else store_f32_64(p.out + (isk ? p.o_pbk : p.o_pbv) + ((size_t)l * RP + row) * 512 + col, v);
    } else if (nt < 21) { const int col = 128 * (nt - 18) + 64 * half;
      store_bf16_64(p.CQraw + (size_t)row * 384 + col, v); p.cqss[(size_t)(2 * (nt - 18) + half) * R + row] = sumsq64(v);
    } else if (nt < 23) { const int col = 128 * (nt - 21) + 64 * half;
      store_bf16_64(p.CKVraw + (size_t)row * 256 + col, v); p.ckvss[(size_t)(2 * (nt - 21) + half) * R + row] = sumsq64(v);
      if (samp) store_f32_64(p.out + p.o_sckv + ((size_t)l * 512 + sr) * 256 + col, v);
      else store_f32_64(p.out + p.o_pckv + ((size_t)l * RP + row) * 256 + col, v);
    } else { if (half == 0) { rope32(v, samp ? 2048 + t : t);
        float* o = samp ? (p.out + p.o_sckpe + ((size_t)l * 512 + sr) * 32) : (p.out + p.o_pckpe + ((size_t)l * RP + row) * 32);
        float* kp = p.KPE + (size_t)row * 32;
#pragma unroll
        for (int c = 0; c < 8; ++c) { f32x4 w = {v[4 * c], v[4 * c + 1], v[4 * c + 2], v[4 * c + 3]}; *(f32x4*)(o + 4 * c) = w; *(f32x4*)(kp + 4 * c) = w; } } }
  } };

struct EpiQc { const Params* pp; int l; int nt;
  static constexpr bool DIRECT = false, NEED_RSTD = false;
  DI void operator()(int row, int half, float (&v)[64]) const {
    const Params& p = *pp; const int h = nt;
    const bool samp = row >= RP; const int sr = row - RP; const int t = samp ? (sr & 63) : (row & 4095);
    scale64(v, rstd_from(p.cqss, 6, R, row, 1.f / 384.f));
    float s;
    if (half) { rope32(v, samp ? 2048 + t : t); s = 0.f;
#pragma unroll
      for (int i = 0; i < 32; ++i) s += v[i] * v[i]; } else s = sumsq64(v);
    s += __shfl_xor(s, 1);
    const float r2 = rsqrtf(s * (1.f / 96.f) + EPS) * (0.10206207261596575f * LOG2E);
    const float* g = p.in[28] + l * 96 + half * 64; bf16_t* dst = p.QC + (size_t)row * 384 + h * 96 + half * 64;
    if (half == 0) { mulgain64(v, g, r2); store_bf16_64(dst, v); }
    else {
#pragma unroll
      for (int i = 0; i < 32; ++i) v[i] *= g[i] * r2;
      store_bf16_32(dst, v); }
  } };

struct EpiKv { const Params* pp; int l; int nt; int mode;
  static constexpr bool DIRECT = false, NEED_RSTD = false;
  DI void operator()(int row, int half, float (&v)[64]) const {
    const Params& p = *pp; const int h = nt;
    size_t krow; const float* kpe; float rs = 1.f;
    if (mode == 0) { const bool samp = row >= RP; const int sr = row - RP;
      krow = samp ? ((size_t)(l * 8 + (sr >> 6)) * 2112 + 2048 + (sr & 63)) : (size_t)row; kpe = p.KPE + (size_t)row * 32;
      rs = rstd_from(p.ckvss, 4, R, row, 1.f / 256.f);
      if (h == 0) {
        float* o = samp ? (p.out + p.o_sckv + ((size_t)l * 512 + sr) * 256) : (p.out + p.o_pckv + ((size_t)l * RP + row) * 256);
        const float* g = p.in[25] + l * 256;
        for (int c = 0; c < 32; ++c) { const int cc = half * 128 + 4 * c; f32x4 x = *(const f32x4*)(o + cc); const f32x4 gg = *(const f32x4*)(g + cc);
          x.x *= rs * gg.x; x.y *= rs * gg.y; x.z *= rs * gg.z; x.w *= rs * gg.w; *(f32x4*)(o + cc) = x; } }
    } else { const int b = row >> 11, pos = row & 2047; krow = (size_t)(l * 8 + b) * 2112 + pos; kpe = p.in[8] + ((size_t)(l * 8 + b) * 2048 + pos) * 32; }
    const bool tosamp = (mode == 1) || (row >= RP);
    scale64(v, rs);
    if (half == 0) { float kp[32]; float s = sumsq64(v);
#pragma unroll
      for (int c = 0; c < 8; ++c) { const f32x4 w = *(const f32x4*)(kpe + 4 * c); kp[4 * c] = w.x; kp[4 * c + 1] = w.y; kp[4 * c + 2] = w.z; kp[4 * c + 3] = w.w; s += w.x * w.x + w.y * w.y + w.z * w.z + w.w * w.w; }
      const float r2 = rsqrtf(s * (1.f / 96.f) + EPS); const float* g = p.in[29] + l * 96;
      mulgain64(v, g, r2);
      bf16_t* dst = (tosamp ? p.SKC : p.PKC) + krow * 384 + h * 96; store_bf16_64(dst, v);
#pragma unroll
      for (int c = 0; c < 4; ++c) { u32x4 w; w.x = pk2(kp[8 * c] * g[64 + 8 * c] * r2, kp[8 * c + 1] * g[65 + 8 * c] * r2); w.y = pk2(kp[8 * c + 2] * g[66 + 8 * c] * r2, kp[8 * c + 3] * g[67 + 8 * c] * r2);
        w.z = pk2(kp[8 * c + 4] * g[68 + 8 * c] * r2, kp[8 * c + 5] * g[69 + 8 * c] * r2); w.w = pk2(kp[8 * c + 6] * g[70 + 8 * c] * r2, kp[8 * c + 7] * g[71 + 8 * c] * r2); *(u32x4*)(dst + 64 + 8 * c) = w; }
    } else { store_bf16_64((tosamp ? p.SVC : p.PVC) + krow * 256 + h * 64, v); }
  } };

struct EpiMemQ { const Params* pp; int l; int nt;
  static constexpr bool DIRECT = false, NEED_RSTD = false;
  DI void operator()(int row, int half, float (&v)[64]) const {
    const Params& p = *pp; const int h = nt;
    scale64(v, rstd_from(p.ss, 16, R, row, 1.f / 1024.f));
    float s = sumsq64(v); s += __shfl_xor(s, 1);
    const float r2 = rsqrtf(s * (1.f / 128.f) + EPS) * (0.08838834764831845f * LOG2E);
    mulgain64(v, p.in[33] + l * 128 + half * 64, r2);
    store_bf16_64(p.QM + (size_t)row * 512 + h * 128 + half * 64, v);
  } };

struct EpiMemKV { const Params* pp; int l; int nt;
  static constexpr bool DIRECT = false, NEED_RSTD = false;
  DI void operator()(int row, int half, float (&v)[64]) const {
    const Params& p = *pp;
    scale64(v, rstd_from(p.memss, 16, 1024, row, 1.f / 1024.f));
    const size_t idx = ((size_t)l * 1024 + row) * 512 + (nt & 3) * 128 + half * 64;
    if (nt < 4) { float s = sumsq64(v); s += __shfl_xor(s, 1); const float r2 = rsqrtf(s * (1.f / 128.f) + EPS);
      mulgain64(v, p.in[37] + l * 128 + half * 64, r2); store_f32_64(p.out + p.o_pmk + idx, v); store_bf16_64(p.MK + idx, v);
    } else { store_f32_64(p.out + p.o_pmv + idx, v); store_bf16_64(p.MV + idx, v); }
  } };

typedef __attribute__((address_space(3))) const char* lds_cptr;
typedef short v4i16_t __attribute__((ext_vector_type(4)));
DI s16x4 vtr(const char* p) { return __builtin_bit_cast(s16x4, __builtin_amdgcn_ds_read_tr16_b64_v4i16((__attribute__((address_space(3))) v4i16_t*)(p))); }

constexpr int ATT_VOFF = 17408, ATT_STAGE = 17408 + 16384, ATT_TAB = 2 * ATT_STAGE;

template <int DQK, int DV, int MODE, bool PF = true>
DI void attn_core(char* smem, const bf16_t* Qrow, const bf16_t* __restrict__ Kb, int ldk, const bf16_t* __restrict__ Vb, int ldv,
                  int T0, int T1, int wlo, int whi, bool active, int qpos, int kpos0, float slope, f32x16 (&o)[DV / 32]) {
  const int tid = ltid(), lane = tid & 63, r32 = lane & 31, hi = lane >> 5;
  constexpr int KSTR = DQK * 2 + 16, KCH = DQK / 8, VCH = DV / 8, NKI = (64 * KCH + NTHR - 1) / NTHR, NVI = (64 * VCH + NTHR - 1) / NTHR, KTOT = 64 * KCH, VTOT = 64 * VCH, NKS = DQK / 16, NDH = DV / 32;
  bf16x8 qr[NKS];
#pragma unroll
  for (int ks = 0; ks < NKS; ++ks) { if (active) qr[ks] = *(const bf16x8*)(Qrow + ks * 16 + hi * 8); else qr[ks] = (bf16x8){0, 0, 0, 0, 0, 0, 0, 0}; }
#pragma unroll
  for (int d = 0; d < NDH; ++d)
#pragma unroll
    for (int i = 0; i < 16; ++i) o[d][i] = 0.f;
  float mhat = 0.f, lsum = 0.f;
  u32x4 kr[NKI], vr[NVI];
  int koff[NKI], voff[NVI]; int klds[NKI], vlds[NVI];
#pragma unroll
  for (int i = 0; i < NKI; ++i) { const int idx = min(tid + NTHR * i, KTOT - 1), key = idx / KCH, ch = idx % KCH; koff[i] = key * ldk + ch * 8; klds[i] = key * KSTR + ch * 16; }
#pragma unroll
  for (int i = 0; i < NVI; ++i) { const int idx = min(tid + NTHR * i, VTOT - 1), key = idx / VCH, ch = idx % VCH; voff[i] = key * ldv + ch * 8; vlds[i] = ATT_VOFF + (ch >> 2) * 4096 + key * 64 + (ch & 3) * 16; }
  const float* tab = (const float*)(smem + ATT_TAB);
  if (PF) {
    if (T0 < T1) {
#pragma unroll
      for (int i = 0; i < NKI; ++i) kr[i] = *(const u32x4*)(Kb + (size_t)T0 * 64 * ldk + koff[i]);
#pragma unroll
      for (int i = 0; i < NVI; ++i) vr[i] = *(const u32x4*)(Vb + (size_t)T0 * 64 * ldv + voff[i]);
#pragma unroll
      for (int i = 0; i < NKI; ++i) *(u32x4*)(smem + klds[i]) = kr[i];
#pragma unroll
      for (int i = 0; i < NVI; ++i) *(u32x4*)(smem + vlds[i]) = vr[i];
      if (T0 + 1 < T1) {
#pragma unroll
        for (int i = 0; i < NKI; ++i) kr[i] = *(const u32x4*)(Kb + (size_t)(T0 + 1) * 64 * ldk + koff[i]);
#pragma unroll
        for (int i = 0; i < NVI; ++i) vr[i] = *(const u32x4*)(Vb + (size_t)(T0 + 1) * 64 * ldv + voff[i]);
      }
    }
    __syncthreads();
#pragma unroll 1
    for (int t = T0; t < T1; ++t) {
      const int cur = (t - T0) & 1;
      const char* sbuf = smem + cur * ATT_STAGE;
      if (t + 1 < T1) {
        char* nb = smem + (cur ^ 1) * ATT_STAGE;
#pragma unroll
        for (int i = 0; i < NKI; ++i) *(u32x4*)(nb + klds[i]) = kr[i];
#pragma unroll
        for (int i = 0; i < NVI; ++i) *(u32x4*)(nb + vlds[i]) = vr[i];
      }
      if (t + 2 < T1) {
#pragma unroll
        for (int i = 0; i < NKI; ++i) kr[i] = *(const u32x4*)(Kb + (size_t)(t + 2) * 64 * ldk + koff[i]);
#pragma unroll
        for (int i = 0; i < NVI; ++i) vr[i] = *(const u32x4*)(Vb + (size_t)(t + 2) * 64 * ldv + voff[i]);
      }
  if (active && t >= wlo && t < whi) {
        f32x16 s0, s1;
#pragma unroll
        for (int i = 0; i < 16; ++i) { s0[i] = 0.f; s1[i] = 0.f; }
        const char* kp = sbuf + r32 * KSTR + hi * 16;
#pragma unroll
        for (int ks = 0; ks < NKS; ++ks) {
          const bf16x8 k0 = *(const bf16x8*)(kp + ks * 32), k1 = *(const bf16x8*)(kp + 32 * KSTR + ks * 32);
          s0 = MFMA32(k0, qr[ks], s0); s1 = MFMA32(k1, qr[ks], s1); }
        __builtin_amdgcn_sched_barrier(0);
        if (MODE != 0) {
          const int dbase = qpos - (kpos0 + 64 * t + 4 * hi); const float fdb = (float)dbase;
#pragma unroll
          for (int i = 0; i < 16; ++i) { const int d0 = dbase - ((i & 3) + 8 * (i >> 2)), d1 = d0 - 32;
            if (MODE == 1) { const int i0 = min(max(d0, -128), 128) + 128, i1 = min(max(d1, -128), 128) + 128; s0[i] += tab[i0]; s1[i] += tab[i1]; }
            else { s0[i] -= slope * fabsf(fdb - (float)((i & 3) + 8 * (i >> 2))); s1[i] -= slope * fabsf(fdb - (float)(32 + (i & 3) + 8 * (i >> 2))); } }
        }
        float mx = fmaxf(s0[0], s1[0]);
#pragma unroll
        for (int i = 1; i < 16; ++i) mx = fmaxf(mx, fmaxf(s0[i], s1[i]));
        { const auto rr = __builtin_amdgcn_permlane32_swap(__float_as_uint(mx), __float_as_uint(mx), false, false);
          mx = fmaxf(__uint_as_float(rr[0]), __uint_as_float(rr[1])); }
        if (t == wlo) mhat = mx;
        else { const float g = mx - mhat;
          if (__any(g > 8.f)) { const float dl = fmaxf(g, 0.f); mhat += dl; const float f = __builtin_amdgcn_exp2f(-dl); lsum *= f;
#pragma unroll
            for (int i = 0; i < 16; ++i) { const float fr = __shfl(f, crow(i, hi));
#pragma unroll
              for (int d = 0; d < NDH; ++d) o[d][i] *= fr; } } }
        float ls = 0.f;
#pragma unroll
        for (int i = 0; i < 16; ++i) { s0[i] = __builtin_amdgcn_exp2f(s0[i] - mhat); s1[i] = __builtin_amdgcn_exp2f(s1[i] - mhat); ls += s0[i] + s1[i]; }
        lsum += ls;
        u32x4 pw[4];
#pragma unroll
        for (int c = 0; c < 4; ++c) { pw[0][c] = pk2(s0[2 * c], s0[2 * c + 1]); pw[1][c] = pk2(s0[8 + 2 * c], s0[9 + 2 * c]); pw[2][c] = pk2(s1[2 * c], s1[2 * c + 1]); pw[3][c] = pk2(s1[8 + 2 * c], s1[9 + 2 * c]); }
        __builtin_amdgcn_sched_barrier(0);
        const char* vp = sbuf + ATT_VOFF + ((lane >> 4) & 1) * 32 + (lane & 3) * 8 + (4 * hi + ((lane & 15) >> 2)) * 64;
#pragma unroll
        for (int s = 0; s < 4; ++s) {
          const bf16x8 pa = __builtin_bit_cast(bf16x8, pw[s]);
#pragma unroll
          for (int d = 0; d < NDH; ++d) {
            const s16x4 lo = vtr(vp + d * 4096 + s * 1024), hh = vtr(vp + d * 4096 + s * 1024 + 512);
            const bf16x8 vf = {lo[0], lo[1], lo[2], lo[3], hh[0], hh[1], hh[2], hh[3]};
            o[d] = MFMA32(pa, vf, o[d]); }
          __builtin_amdgcn_sched_barrier(0); }
      }
      __syncthreads();
    }
  } else {
#pragma unroll 1
    for (int t = T0; t < T1; ++t) {
#pragma unroll
      for (int i = 0; i < NKI; ++i) kr[i] = *(const u32x4*)(Kb + (size_t)t * 64 * ldk + koff[i]);
#pragma unroll
      for (int i = 0; i < NVI; ++i) vr[i] = *(const u32x4*)(Vb + (size_t)t * 64 * ldv + voff[i]);
      __syncthreads();
#pragma unroll
      for (int i = 0; i < NKI; ++i) *(u32x4*)(smem + klds[i]) = kr[i];
#pragma unroll
      for (int i = 0; i < NVI; ++i) *(u32x4*)(smem + vlds[i]) = vr[i];
      __syncthreads();
      const char* sbuf = smem;
  if (active && t >= wlo && t < whi) {
        f32x16 s0, s1;
#pragma unroll
        for (int i = 0; i < 16; ++i) { s0[i] = 0.f; s1[i] = 0.f; }
        const char* kp = sbuf + r32 * KSTR + hi * 16;
#pragma unroll
        for (int ks = 0; ks < NKS; ++ks) {
          const bf16x8 k0 = *(const bf16x8*)(kp + ks * 32), k1 = *(const bf16x8*)(kp + 32 * KSTR + ks * 32);
          s0 = MFMA32(k0, qr[ks], s0); s1 = MFMA32(k1, qr[ks], s1); }
        __builtin_amdgcn_sched_barrier(0);
        if (MODE != 0) {
          const int dbase = qpos - (kpos0 + 64 * t + 4 * hi); const float fdb = (float)dbase;
#pragma unroll
          for (int i = 0; i < 16; ++i) { const int d0 = dbase - ((i & 3) + 8 * (i >> 2)), d1 = d0 - 32;
            if (MODE == 1) { const int i0 = min(max(d0, -128), 128) + 128, i1 = min(max(d1, -128), 128) + 128; s0[i] += tab[i0]; s1[i] += tab[i1]; }
            else { s0[i] -= slope * fabsf(fdb - (float)((i & 3) + 8 * (i >> 2))); s1[i] -= slope * fabsf(fdb - (float)(32 + (i & 3) + 8 * (i >> 2))); } }
        }
        float mx = fmaxf(s0[0], s1[0]);
#pragma unroll
        for (int i = 1; i < 16; ++i) mx = fmaxf(mx, fmaxf(s0[i], s1[i]));
        { const auto rr = __builtin_amdgcn_permlane32_swap(__float_as_uint(mx), __float_as_uint(mx), false, false);
          mx = fmaxf(__uint_as_float(rr[0]), __uint_as_float(rr[1])); }
        if (t == wlo) mhat = mx;
        else { const float g = mx - mhat;
          if (__any(g > 8.f)) { const float dl = fmaxf(g, 0.f); mhat += dl; const float f = __builtin_amdgcn_exp2f(-dl); lsum *= f;
#pragma unroll
            for (int i = 0; i < 16; ++i) { const float fr = __shfl(f, crow(i, hi));
#pragma unroll
              for (int d = 0; d < NDH; ++d) o[d][i] *= fr; } } }
        float ls = 0.f;
#pragma unroll
        for (int i = 0; i < 16; ++i) { s0[i] = __builtin_amdgcn_exp2f(s0[i] - mhat); s1[i] = __builtin_amdgcn_exp2f(s1[i] - mhat); ls += s0[i] + s1[i]; }
        lsum += ls;
        u32x4 pw[4];
#pragma unroll
        for (int c = 0; c < 4; ++c) { pw[0][c] = pk2(s0[2 * c], s0[2 * c + 1]); pw[1][c] = pk2(s0[8 + 2 * c], s0[9 + 2 * c]); pw[2][c] = pk2(s1[2 * c], s1[2 * c + 1]); pw[3][c] = pk2(s1[8 + 2 * c], s1[9 + 2 * c]); }
        __builtin_amdgcn_sched_barrier(0);
        const char* vp = sbuf + ATT_VOFF + ((lane >> 4) & 1) * 32 + (lane & 3) * 8 + (4 * hi + ((lane & 15) >> 2)) * 64;
#pragma unroll
        for (int s = 0; s < 4; ++s) {
          const bf16x8 pa = __builtin_bit_cast(bf16x8, pw[s]);
#pragma unroll
          for (int d = 0; d < NDH; ++d) {
            const s16x4 lo = vtr(vp + d * 4096 + s * 1024), hh = vtr(vp + d * 4096 + s * 1024 + 512);
            const bf16x8 vf = {lo[0], lo[1], lo[2], lo[3], hh[0], hh[1], hh[2], hh[3]};
            o[d] = MFMA32(pa, vf, o[d]); }
          __builtin_amdgcn_sched_barrier(0); }
      }
    }
  }
  if (active) {
    lsum += __shfl_xor(lsum, 32);
    const float linv = 1.f / lsum;
#pragma unroll
    for (int i = 0; i < 16; ++i) { const float li = __shfl(linv, crow(i, hi));
#pragma unroll
      for (int d = 0; d < NDH; ++d) o[d][i] *= li; }
  }
}

template <int NDH>
DI void store_o(bf16_t* dst  , int ld, const f32x16 (&o)[NDH], int r32, int hi) {
#pragma unroll
  for (int i = 0; i < 16; ++i) { bf16_t* rp = dst + (size_t)crow(i, hi) * ld + r32;
#pragma unroll
    for (int d = 0; d < NDH; ++d) rp[32 * d] = (bf16_t)(pk2(o[d][i], 0.f) & 0xffffu); }
}

DI void attn_job(char* smem, const Params& p, int l, int kind, bool samp, int b, int h, int qt, int q) {
  const int tid = ltid(), lane = tid & 63, wid = tid >> 6, r32 = lane & 31, hi = lane >> 5, ch4 = wid >> 1;
  const int row0 = samp ? (RP + 64 * b) : (b * 4096 + 256 * qt);
  const int wrow = row0 + 32 * wid;
  const bool active = samp ? (wid < 2) : true;
  const int qpos = (samp ? 2048 : 256 * qt) + 32 * wid + r32;
  const int cq = 4 * qt + ch4;
  __syncthreads();
  if (kind == 0) {
    { float* tab = (float*)(smem + ATT_TAB); const float* src = p.in[19] + (size_t)(l * 4 + h) * 257; for (int i = tid; i < 257; i += NTHR) tab[i] = src[i] * LOG2E; }
    int T0, T1, wlo, whi, kpos0; const bf16_t *K, *V;
    if (samp) { T0 = 0; T1 = 9; wlo = 0; whi = 9; kpos0 = 1536; K = p.SKA + (size_t)(l * 8 + b) * 576 * 256 + h * 64; V = p.SVA + (size_t)(l * 8 + b) * 576 * 256 + h * 64; }
    else { T0 = max(0, 4 * qt - 8); T1 = 4 * qt + 4; wlo = max(0, cq - 8); whi = cq + 1; kpos0 = 0; K = p.PKA + (size_t)b * 4096 * 256 + h * 64; V = p.PVA + (size_t)b * 4096 * 256 + h * 64; }
    f32x16 o[2];
    attn_core<64, 64, 1>(smem, p.QA + (size_t)(wrow + r32) * 256 + h * 64, K, 256, V, 256, T0, T1, wlo, whi, active, qpos, kpos0, 0.f, o);
    if (active) store_o<2>(p.OMIX + (size_t)wrow * 1024 + h * 64, 1024, o, r32, hi);
  } else if (kind == 2) {
    const bf16_t *K, *V; int T1, whi;
    if (samp) { T1 = 33; whi = 33; K = p.SKC + (size_t)(l * 8 + b) * 2112 * 384 + h * 96; V = p.SVC + (size_t)(l * 8 + b) * 2112 * 256 + h * 64; }
    else { T1 = 4 * qt + 4; whi = cq + 1; K = p.PKC + (size_t)b * 4096 * 384 + h * 96; V = p.PVC + (size_t)b * 4096 * 256 + h * 64; }
    f32x16 o[2];
    attn_core<96, 64, 0>(smem, p.QC + (size_t)(wrow + r32) * 384 + h * 96, K, 384, V, 256, 0, T1, 0, whi, active, qpos, 0, 0.f, o);
    if (active) store_o<2>(p.OMIX + (size_t)wrow * 1024 + 768 + h * 64, 1024, o, r32, hi);
  } else {
    const bf16_t *K, *V; int T1, whi;
    if (samp) { T1 = 33; whi = 33; K = p.SKB + (size_t)(l * 8 + b) * 2112 * 512; V = p.SVB + (size_t)(l * 8 + b) * 2112 * 512 + h * 128; }
    else { T1 = 4 * qt + 4; whi = cq + 1; K = p.PKB + (size_t)b * 4096 * 512; V = p.PVB + (size_t)b * 4096 * 512 + h * 128; }
    const float slope = exp2f(-2.f * (float)(h + 1)) * LOG2E;
    const int jj = (kind == 3) ? 1 : 0;
    f32x16 o[4];
    attn_core<64, 128, 2>(smem, p.QB + (size_t)(wrow + r32) * 512 + (h * 2 + jj) * 64, K + (h * 2 + jj) * 64, 512, V, 512, 0, T1, 0, whi, active, qpos, 0, slope, o);
    float* ob = p.OB0 + (size_t)wrow * 512 + h * 128 + r32;
    unsigned* flag = p.bflag + l * NAJ + q;
    if (jj == 0) {
      if (active) {
#pragma unroll
        for (int i = 0; i < 16; ++i)
#pragma unroll
          for (int d = 0; d < 4; ++d) ob[(size_t)crow(i, hi) * 512 + 32 * d] = o[d][i];
      }
      asm volatile("s_waitcnt vmcnt(0)" ::: "memory");
      __syncthreads();
      if (tid == 0) { __builtin_amdgcn_fence(__ATOMIC_RELEASE, "agent"); asm volatile("s_waitcnt vmcnt(0)" ::: "memory");
        __hip_atomic_store(flag, 1u, __ATOMIC_RELAXED, __HIP_MEMORY_SCOPE_AGENT); }
    } else {
      float lam;
      { const float* bl = p.in[22] + (size_t)l * 256; float p1 = bl[lane] * bl[64 + lane], p2 = bl[128 + lane] * bl[192 + lane];
#pragma unroll
        for (int m = 1; m < 64; m <<= 1) { p1 += __shfl_xor(p1, m); p2 += __shfl_xor(p2, m); }
        lam = expf(p1) - expf(p2) + p.lam_init[l]; }
      if (tid == 0) { unsigned sp = 0u; while (__hip_atomic_load(flag, __ATOMIC_RELAXED, __HIP_MEMORY_SCOPE_AGENT) == 0u && ++sp < (1u << 20)) __builtin_amdgcn_s_sleep(2);
        __builtin_amdgcn_fence(__ATOMIC_ACQUIRE, "agent"); asm volatile("s_waitcnt vmcnt(0)" ::: "memory"); }
      __syncthreads();
      if (active) {
        const float* gsub = p.in[23] + l * 128; const float omz = 1.f - p.lam_init[l];
#pragma unroll
        for (int i = 0; i < 16; ++i)
#pragma unroll
          for (int d = 0; d < 4; ++d) o[d][i] = ob[(size_t)crow(i, hi) * 512 + 32 * d] - lam * o[d][i];
#pragma unroll
        for (int i = 0; i < 16; ++i) { float sq = o[0][i] * o[0][i] + o[1][i] * o[1][i] + o[2][i] * o[2][i] + o[3][i] * o[3][i];
          sq += __shfl_xor(sq, 1); sq += __shfl_xor(sq, 2); sq += __shfl_xor(sq, 4); sq += __shfl_xor(sq, 8); sq += __shfl_xor(sq, 16);
          const float r2 = rsqrtf(sq * (1.f / 128.f) + EPS) * omz;
#pragma unroll
          for (int d = 0; d < 4; ++d) o[d][i] *= r2 * gsub[32 * d + r32]; }
        store_o<4>(p.OMIX + (size_t)wrow * 1024 + 256 + h * 128, 1024, o, r32, hi);
      }
    }
  }
}

DI void mem_attn(char* smem, const Params& p, int l, int row0, int nrows, int h, const bf16_t* K, const bf16_t* V) {
  const int tid = ltid(), lane = tid & 63, wid = tid >> 6, r32 = lane & 31, hi = lane >> 5;
  const bool active = 32 * wid < nrows; const int wrow = row0 + 32 * wid;
  f32x16 o[4];
  __syncthreads();
  attn_core<128, 128, 0, false>(smem, p.QM + (size_t)(wrow + r32) * 512 + h * 128, K + h * 128, 512, V + h * 128, 512, 0, 4, 0, 4, active, 0, 0, 0.f, o);
  if (active) store_o<4>(p.OM + (size_t)wrow * 512 + h * 128, 512, o, r32, hi);
}

constexpr int WT_PER_LAYER = 352 * 2 + 176 * 2 + 192 + 12 + 8 + 8 + 64 + 32 + 64 + 32;
DI void wt_job(char* smem, const Params& p, int job) {
  const int l = job / WT_PER_LAYER; int r = job % WT_PER_LAYER;
  bf16_t* dst; int K, ntk, map; const float* gain = nullptr; const float* s0; const float* s1 = nullptr; int ldsrc;
  if (r < 352) { dst = p.Wgu1 + (size_t)l * 5632 * 1024; K = 1024; map = 1; gain = p.in[11] + l * 1024; s0 = p.in[12] + (size_t)l * 1024 * 2816; s1 = p.in[13] + (size_t)l * 1024 * 2816; ldsrc = 2816; }
  else if ((r -= 352) < 176) { dst = p.Wd1 + (size_t)l * 1024 * 2816; K = 2816; map = 0; s0 = p.in[14] + (size_t)l * 2816 * 1024; ldsrc = 1024; }
  else if ((r -= 176) < 192) { dst = p.Win + (size_t)l * 3072 * 1024; K = 1024; map = 0; gain = p.in[15] + l * 1024; s0 = p.in[16] + (size_t)l * 1024 * 2976; ldsrc = 2976; }
  else if ((r -= 192) < 12) { dst = p.Wuq + (size_t)l * 512 * 384; K = 384; map = 2; gain = p.in[24] + l * 384; s0 = p.in[26] + (size_t)l * 384 * 384; ldsrc = 384; }
  else if ((r -= 12) < 8) { dst = p.Wukv + (size_t)l * 512 * 256; K = 256; map = 0; gain = p.in[25] + l * 256; s0 = p.in[27] + (size_t)l * 256 * 512; ldsrc = 512; }
  else if ((r -= 8) < 8) { dst = p.Wukvu + (size_t)l * 512 * 256; K = 256; map = 0; s0 = p.in[27] + (size_t)l * 256 * 512; ldsrc = 512; }
  else if ((r -= 8) < 64) { dst = p.Wout + (size_t)l * 1024 * 1024; K = 1024; map = 0; s0 = p.in[30] + (size_t)l * 1024 * 1024; ldsrc = 1024; }
  else if ((r -= 64) < 32) { dst = p.Wmq + (size_t)l * 512 * 1024; K = 1024; map = 0; gain = p.in[31] + l * 1024; s0 = p.in[32] + (size_t)l * 1024 * 512; ldsrc = 512; }
  else if ((r -= 32) < 64) { dst = p.Wmkv + (size_t)l * 1024 * 1024; K = 1024; map = 3; gain = p.in[34] + l * 1024; s0 = p.in[35] + (size_t)l * 1024 * 512; s1 = p.in[36] + (size_t)l * 1024 * 512; ldsrc = 512; }
  else if ((r -= 64) < 32) { dst = p.Wmo + (size_t)l * 1024 * 512; K = 512; map = 0; s0 = p.in[38] + (size_t)l * 512 * 1024; ldsrc = 1024; }
  else if ((r -= 32) < 352) { dst = p.Wgu2 + (size_t)l * 5632 * 1024; K = 1024; map = 1; gain = p.in[39] + l * 1024; s0 = p.in[40] + (size_t)l * 1024 * 2816; s1 = p.in[41] + (size_t)l * 1024 * 2816; ldsrc = 2816; }
  else { r -= 352; dst = p.Wd2 + (size_t)l * 1024 * 2816; K = 2816; map = 0; s0 = p.in[42] + (size_t)l * 2816 * 1024; ldsrc = 1024; }
  ntk = K >> 6;
  const int n0 = (r / ntk) * 256, k0 = (r % ntk) * 64;
  const int tid = ltid();
  float* lf = (float*)smem;
  { const int c4 = tid & 63, kq = tid >> 6; const int np = n0 + 4 * c4; const float* src = s0; int col;
    if (map == 0) col = np < ldsrc ? np : -1;
    else if (map == 1) { const int w = np & 63, sub = w >> 4; col = (np >> 6) * 32 + (sub >> 1) * 16 + (w & 15); if (sub & 1) src = s1; }
    else if (map == 2) { col = (np & 127) < 96 ? (np >> 7) * 96 + (np & 127) : -1; }
    else { if (np < 512) col = np; else { col = np - 512; src = s1; } }
#pragma unroll
    for (int i = 0; i < 8; ++i) { const int kl = kq + 8 * i; f32x4 x = {0.f, 0.f, 0.f, 0.f};
      if (col >= 0) { x = *(const f32x4*)(src + (size_t)(k0 + kl) * ldsrc + col); if (gain) { const float g = gain[k0 + kl]; x.x *= g; x.y *= g; x.z *= g; x.w *= g; } }
      *(f32x4*)(lf + kl * 260 + 4 * c4) = x; } }
  __syncthreads();
  { const int nl = tid >> 1, kh = (tid & 1) * 32; float x[32];
#pragma unroll
    for (int j = 0; j < 32; ++j) x[j] = lf[(kh + j) * 260 + nl];
    bf16_t* d = dst + (size_t)(n0 + nl) * K + k0 + kh;
#pragma unroll
    for (int c = 0; c < 4; ++c) { u32x4 w = {pk2(x[8 * c], x[8 * c + 1]), pk2(x[8 * c + 2], x[8 * c + 3]), pk2(x[8 * c + 4], x[8 * c + 5]), pk2(x[8 * c + 6], x[8 * c + 7])}; *(u32x4*)(d + 8 * c) = w; } }
  __syncthreads();
}

DI void rowprep_job(const Params& p, int job, bool mem) {
  const int tid = ltid(), lane = tid & 63, wid = tid >> 6; const int row = 8 * job + wid;
  const float* src = mem ? (p.in[2] + (size_t)row * DM) : (row < RP ? p.in[0] + (size_t)row * DM : p.in[1] + (size_t)(row - RP) * DM);
  f32x4 x[4]; float s = 0.f;
#pragma unroll
  for (int c = 0; c < 4; ++c) { x[c] = *(const f32x4*)(src + lane * 16 + 4 * c); s += x[c].x * x[c].x + x[c].y * x[c].y + x[c].z * x[c].z + x[c].w * x[c].w; }
  if (!mem) {
#pragma unroll
    for (int c = 0; c < 4; ++c) *(f32x4*)(p.out + (size_t)row * DM + lane * 16 + 4 * c) = x[c]; }
  bf16_t* d = (mem ? p.MEMb : p.Xb) + (size_t)row * DM + lane * 16;
  u32x4 w0 = {pk2(x[0].x, x[0].y), pk2(x[0].z, x[0].w), pk2(x[1].x, x[1].y), pk2(x[1].z, x[1].w)}, w1 = {pk2(x[2].x, x[2].y), pk2(x[2].z, x[2].w), pk2(x[3].x, x[3].y), pk2(x[3].z, x[3].w)};
  *(u32x4*)d = w0; *(u32x4*)(d + 8) = w1;
  s += __shfl_xor(s, 1); s += __shfl_xor(s, 2);
  if ((lane & 3) == 0) { if (mem) p.memss[(size_t)(lane >> 2) * 1024 + row] = s; else p.ss[(size_t)(lane >> 2) * R + row] = s; }
}

DI void conv_job(const float* src, bf16_t* dst, int job, int chunk, int dstride) {
  const size_t e = (size_t)job * 4096 + ltid() * 8;
  const f32x4 a = *(const f32x4*)(src + e), b = *(const f32x4*)(src + e + 4);
  u32x4 w = {pk2(a.x, a.y), pk2(a.z, a.w), pk2(b.x, b.y), pk2(b.z, b.w)};
  const size_t q = e / (size_t)chunk, rm = e % (size_t)chunk;
  *(u32x4*)(dst + q * (size_t)dstride + rm) = w;
}


DI void gemm_decode(int j, int MT, int NT, int& m, int& n) {
  const int rowsz = 8 * NT, sm = j / rowsz, jr = j - sm * rowsz, rows = min(8, MT - 8 * sm), nfull = NT >> 3, blk = rows * 8;
  int sn, w, local;
  if (jr < nfull * blk) { sn = jr / blk; w = 8; local = jr - sn * blk; } else { sn = nfull; w = NT - 8 * nfull; local = jr - nfull * blk; }
  const int ni = local / rows; m = 8 * sm + (local - ni * rows); n = 8 * sn + ni; }
DI bool gemm_job(int it, int MT, int NT, int& m, int& n) {
  const int G = gridDim.x, bid = blockIdx.x, per = G >> 3;
  if (it >= (MT * NT) / G) return false;
  gemm_decode((it * 8 + (bid & 7)) * per + (bid >> 3), MT, NT, m, n); return true; }
DI bool gemm_tail(int it, int MT, int NT, int& m, int& n, int& half) {
  const int G = gridDim.x, t = blockIdx.x + it * G, tot = MT * NT, base = (tot / G) * G, L = tot - base;
  if (t >= 2 * L) return false;
  gemm_decode(base + (t >> 1), MT, NT, m, n); half = t & 1; return true; }

template <int SEL>
DI void run_phase(const Params& p, char* smem, int ph) {
  const int G = gridDim.x, bid = blockIdx.x;
#ifdef ONLY_S
  if (ph < 2 && ONLY_S < 10) return;
  if (ph >= 2 && ONLY_S >= 10) return;
#endif
  if (ph == 0) {
    constexpr int NWT = WT_PER_LAYER * NL;
    constexpr int J1 = NWT, J2 = J1 + R / 8, J3 = J2 + 128, J4 = J3 + 1024, J5 = J4 + 1024, J6 = J5 + 8192, J7 = J6 + 8192, J8 = J7 + 1024, J9 = J8 + 1024, J10 = J9 + 4096;
    for (int j = bid; j < J10; j += G) {
      if (j < J1) wt_job(smem, p, j);
      else if (j < J2) rowprep_job(p, j - J1, false);
      else if (j < J3) rowprep_job(p, j - J2, true);
      else if (j < J4) conv_job(p.in[3], p.SKA, j - J3, 512 * 256, 576 * 256);
      else if (j < J5) conv_job(p.in[4], p.SVA, j - J4, 512 * 256, 576 * 256);
      else if (j < J6) conv_job(p.in[5], p.SKB, j - J5, 2048 * 512, 2112 * 512);
      else if (j < J7) conv_job(p.in[6], p.SVB, j - J6, 2048 * 512, 2112 * 512);
      else if (j < J8) conv_job(p.in[9], p.SKM, j - J7, 256 * 512, 256 * 512);
      else if (j < J9) conv_job(p.in[10], p.SVM, j - J8, 256 * 512, 256 * 512);
      else conv_job(p.in[7], p.CCKVb, j - J9, 2048 * 256, 2048 * 256);
    }
    return;
  }
  if (ph == 1) {
    for (int j = bid; j < 128 + 1024; j += G) {
      if (j < 128) { const int l = j >> 5, m = (j >> 2) & 7, n = j & 3;
        gemm_unit<4>(smem, p.MEMb, 1024, p.Wmkv + (size_t)l * 1024 * 1024, 1024, 1024, m * 128, n * 256, EpiMemKV{&p, l, 0});
      } else { const int q = j - 128, l = q >> 8, m = (q >> 1) & 127, n = q & 1;
        gemm_unit<4>(smem, p.CCKVb + (size_t)l * 16384 * 256, 256, p.Wukvu + (size_t)l * 512 * 256, 256, 256, m * 128, n * 256, EpiKv{&p, l, 0, 1}); }
    }
    return;
  }
  const int l = (ph - 2) / 10, s = (ph - 2) % 10;
#ifdef ONLY_S
  if (s != ONLY_S) return;
#endif
  if (s == 0 || s == 8) {
    const bf16_t* W = p.Wgu1 + (size_t)((s == 0 ? 0 : NL) + l) * 5632 * 1024;
    for (int it = 0;; ++it) { int m, n; if (!gemm_job(it, 66, 22, m, n)) break;
      gemm_unit<8>(smem, p.Xb, 1024, W, 1024, 1024, m * 256, n * 256, EpiFfnUp{p.ss, p.H, 0}); }
    for (int it = 0;; ++it) { int m, n, hf; if (!gemm_tail(it, 66, 22, m, n, hf)) break;
      gemm_unit<4>(smem, p.Xb, 1024, W, 1024, 1024, m * 256 + 128 * hf, n * 256, EpiFfnUp{p.ss, p.H, 0}); }
  } else if (s == 1 || s == 9) {
    const bf16_t* W = p.Wd1 + (size_t)((s == 1 ? 0 : NL) + l) * 1024 * 2816;
    for (int j = bid; j < 256; j += G) gemm_unit<8>(smem, p.H, DFF, W, DFF, DFF, (j >> 2) * 256, (j & 3) * 256, EpiResid{p.out, p.Xb, p.ss, 0, 0.5f});
    for (int t = bid; t < 32; t += G) gemm_unit<2>(smem, p.H, DFF, W, DFF, DFF, RP + 64 * (t >> 2), (t & 3) * 256, EpiResid{p.out, p.Xb, p.ss, 0, 0.5f});
  } else if (s == 2) {
    const bf16_t* W = p.Win + (size_t)l * 3072 * 1024;
    for (int it = 0;; ++it) { int m, n; if (!gemm_job(it, 132, 12, m, n)) break;
      gemm_unit<4>(smem, p.Xb, 1024, W, 1024, 1024, m * 128, n * 256, EpiProj{&p, l, 0}); }
    for (int it = 0;; ++it) { int m, n, hf; if (!gemm_tail(it, 132, 12, m, n, hf)) break;
      gemm_unit<2>(smem, p.Xb, 1024, W, 1024, 1024, m * 128 + 64 * hf, n * 256, EpiProj{&p, l, 0}); }
  } else if (s == 3) {
    for (int j = bid; j < 132 * 4; j += G) { const int m = j >> 2, n = (j >> 1) & 1;
      if (j & 1) gemm_unit<4>(smem, p.CKVraw, 256, p.Wukv + (size_t)l * 512 * 256, 256, 256, m * 128, n * 256, EpiKv{&p, l, 0, 0});
      else gemm_unit<4>(smem, p.CQraw, 384, p.Wuq + (size_t)l * 512 * 384, 384, 384, m * 128, n * 256, EpiQc{&p, l, 0}); }
  } else if (s == 4) {
    constexpr int NJ = 4 * NAJ;
    int* sj = (int*)(smem + 72000);
    for (;;) {
      __syncthreads();
      if (threadIdx.x == 0) *sj = (int)__hip_atomic_fetch_add(p.actr + l, 1u, __ATOMIC_RELAXED, __HIP_MEMORY_SCOPE_AGENT);
      __syncthreads();
      const int j = *sj; if (j >= NJ) break;
      const int grp = j / NAJ, q = j % NAJ; const int kind = grp == 0 ? 1 : (grp == 1 ? 3 : (grp == 2 ? 2 : 0));
      const bool sm = q >= 256;
      attn_job(smem, p, l, kind, sm, sm ? ((q - 256) >> 2) : ((q >> 2) & 3), q & 3, sm ? 0 : 15 - (q >> 4), q); }
  } else if (s == 5) {
    const bf16_t* W = p.Wout + (size_t)l * 1024 * 1024;
    for (int j = bid; j < 256; j += G) gemm_unit<8>(smem, p.OMIX, 1024, W, 1024, 1024, (j >> 2) * 256, (j & 3) * 256, EpiResid{p.out, p.Xb, p.ss, 0, 1.0f});
    for (int t = bid; t < 32; t += G) gemm_unit<2>(smem, p.OMIX, 1024, W, 1024, 1024, RP + 64 * (t >> 2), (t & 3) * 256, EpiResid{p.out, p.Xb, p.ss, 0, 1.0f});
  } else if (s == 6) {
    const bf16_t* W = p.Wmq + (size_t)l * 512 * 1024;
    for (int j = bid; j < 128 + 16; j += G) {
      if (j < 128) { const int m = j >> 1, n = j & 1, b = m >> 4;
        gemm_unit<4>(smem, p.Xb, 1024, W, 1024, 1024, m * 256, n * 256, EpiMemQ{&p, l, 0});
        gemm_unit<4>(smem, p.Xb, 1024, W, 1024, 1024, m * 256 + 128, n * 256, EpiMemQ{&p, l, 0});
        __syncthreads();
        for (int u = 0; u < 2; ++u) mem_attn(smem, p, l, m * 256, 256, 2 * n + u, p.MK + (size_t)(l * 4 + b) * 256 * 512, p.MV + (size_t)(l * 4 + b) * 256 * 512);
      } else { const int sb = (j - 128) >> 1, n = j & 1;
        gemm_unit<2>(smem, p.Xb, 1024, W, 1024, 1024, RP + 64 * sb, n * 256, EpiMemQ{&p, l, 0});
        __syncthreads();
        for (int u = 0; u < 2; ++u) mem_attn(smem, p, l, RP + 64 * sb, 64, 2 * n + u, p.SKM + (size_t)(l * 8 + sb) * 256 * 512, p.SVM + (size_t)(l * 8 + sb) * 256 * 512); }
    }
  } else if (s == 7) {
    const bf16_t* W = p.Wmo + (size_t)l * 1024 * 512;
    for (int j = bid; j < 256; j += G) gemm_unit<8>(smem, p.OM, 512, W, 512, 512, (j >> 2) * 256, (j & 3) * 256, EpiResid{p.out, p.Xb, p.ss, 0, 1.0f});
    for (int t = bid; t < 32; t += G) gemm_unit<2>(smem, p.OM, 512, W, 512, 512, RP + 64 * (t >> 2), (t & 3) * 256, EpiResid{p.out, p.Xb, p.ss, 0, 1.0f});
  }
}

__global__ void __launch_bounds__(NTHR, 2) mega(Params p, int ph_lo, int ph_hi) {
  __shared__ __attribute__((aligned(16))) char smem[LDS_BYTES];
  __shared__ uint4 xb_words;
  if (ph_hi < 0) { cg::this_grid().sync(); }
  if (threadIdx.x == 0) xb_words = make_uint4(0u, 0u, 0u, 0u);
  __syncthreads();
  XcdBarrier xb = xcd_barrier_post(p.bar, (volatile LAS unsigned*)&xb_words);
  for (int ph = ph_lo; ph < ph_hi; ++ph) {
    run_phase<-1>(p, smem, ph);
#if REP_UP
    if (ph >= 2 && ((ph - 2) % 10 == 0 || (ph - 2) % 10 == 8)) { xcd_barrier(xb); run_phase<-1>(p, smem, ph); }
#endif
#if REP_ATT
    if (ph >= 2 && ((ph - 2) % 10 == 4)) { xcd_barrier(xb); run_phase<-1>(p, smem, ph); }
#endif
    if (ph + 1 < ph_hi) xcd_barrier(xb);
#if REP_SYNC
    if (ph + 1 < ph_hi) xcd_barrier(xb);
#endif
  }
}

#ifndef MK_MULTI
#define MK_MULTI 0
#endif

extern "C" void kernel_launch(void* const* d_in, const int* in_sizes, int n_in, void* d_out, int out_size, void* d_ws, size_t ws_size, hipStream_t stream) {
  Params p; memset(&p, 0, sizeof(p));
  for (int i = 0; i < 43; ++i) p.in[i] = (const float*)d_in[i];
  p.out = (float*)d_out;
  long off = 0;
  auto take = [&](long n) { long o = off; off += n; return o; };
  take((long)RP * DM); p.o_ys = take(512L * DM);
  p.o_pak = take(4L * 4 * 512 * 256); p.o_pav = take(4L * 4 * 512 * 256);
  p.o_pbk = take(4L * RP * 512); p.o_pbv = take(4L * RP * 512);
  p.o_pckv = take(4L * RP * 256); p.o_pckpe = take(4L * RP * 32);
  p.o_pmk = take(4L * 4 * 256 * 512); p.o_pmv = take(4L * 4 * 256 * 512);
  p.o_sak = take(4L * 512 * 256); p.o_sav = take(4L * 512 * 256);
  p.o_sbk = take(4L * 512 * 512); p.o_sbv = take(4L * 512 * 512);
  p.o_sckv = take(4L * 512 * 256); p.o_sckpe = take(4L * 512 * 32);
  char* ws = (char*)d_ws; size_t wo = 0;
  auto alloc = [&](size_t bytes) { char* r = ws + wo; wo += (bytes + 255) & ~(size_t)255; return r; };
  p.Wgu1 = (bf16_t*)alloc((size_t)2 * NL * 5632 * 1024 * 2); p.Wd1 = (bf16_t*)alloc((size_t)2 * NL * 1024 * 2816 * 2);
  p.Wgu2 = p.Wgu1 + (size_t)NL * 5632 * 1024; p.Wd2 = p.Wd1 + (size_t)NL * 1024 * 2816;
  p.Win = (bf16_t*)alloc((size_t)NL * 3072 * 1024 * 2); p.Wuq = (bf16_t*)alloc((size_t)NL * 512 * 384 * 2);
  p.Wukv = (bf16_t*)alloc((size_t)NL * 512 * 256 * 2); p.Wukvu = (bf16_t*)alloc((size_t)NL * 512 * 256 * 2);
  p.Wout = (bf16_t*)alloc((size_t)NL * 1024 * 1024 * 2); p.Wmq = (bf16_t*)alloc((size_t)NL * 512 * 1024 * 2);
  p.Wmkv = (bf16_t*)alloc((size_t)NL * 1024 * 1024 * 2); p.Wmo = (bf16_t*)alloc((size_t)NL * 1024 * 512 * 2);
  p.Xb = (bf16_t*)alloc((size_t)R * 1024 * 2);
  const size_t ubase = wo;
  p.OMIX = (bf16_t*)alloc((size_t)R * 1024 * 2); p.QA = (bf16_t*)alloc((size_t)R * 256 * 2); p.QB = (bf16_t*)alloc((size_t)R * 512 * 2);
  p.QC = (bf16_t*)alloc((size_t)R * 384 * 2); p.CQraw = (bf16_t*)alloc((size_t)R * 384 * 2); p.CKVraw = (bf16_t*)alloc((size_t)R * 256 * 2);
  p.PKA = (bf16_t*)alloc((size_t)RP * 256 * 2); p.PVA = (bf16_t*)alloc((size_t)RP * 256 * 2);
  p.PKB = (bf16_t*)alloc((size_t)RP * 512 * 2); p.PVB = (bf16_t*)alloc((size_t)RP * 512 * 2);
  p.PKC = (bf16_t*)alloc((size_t)RP * 384 * 2); p.PVC = (bf16_t*)alloc((size_t)RP * 256 * 2);
  p.H = (bf16_t*)(ws + ubase);
  if (wo - ubase < (size_t)R * DFF * 2) wo = ubase + (size_t)R * DFF * 2;
  p.OM = (bf16_t*)alloc((size_t)R * 512 * 2); p.QM = (bf16_t*)alloc((size_t)R * 512 * 2);
  p.SKA = (bf16_t*)alloc((size_t)NL * 8 * 576 * 256 * 2); p.SVA = (bf16_t*)alloc((size_t)NL * 8 * 576 * 256 * 2);
  p.SKB = (bf16_t*)alloc((size_t)NL * 8 * 2112 * 512 * 2); p.SVB = (bf16_t*)alloc((size_t)NL * 8 * 2112 * 512 * 2);
  p.SKC = (bf16_t*)alloc((size_t)NL * 8 * 2112 * 384 * 2); p.SVC = (bf16_t*)alloc((size_t)NL * 8 * 2112 * 256 * 2);
  p.SKM = (bf16_t*)alloc((size_t)NL * 8 * 256 * 512 * 2); p.SVM = (bf16_t*)alloc((size_t)NL * 8 * 256 * 512 * 2);
  p.MK = (bf16_t*)alloc((size_t)NL * 4 * 256 * 512 * 2); p.MV = (bf16_t*)alloc((size_t)NL * 4 * 256 * 512 * 2);
  p.MEMb = (bf16_t*)alloc((size_t)1024 * 1024 * 2); p.CCKVb = (bf16_t*)alloc((size_t)NL * 8 * 2048 * 256 * 2);
  p.ss = (float*)alloc((size_t)16 * R * 4); p.memss = (float*)alloc((size_t)16 * 1024 * 4);
  p.cqss = (float*)alloc((size_t)6 * R * 4); p.ckvss = (float*)alloc((size_t)4 * R * 4); p.KPE = (float*)alloc((size_t)R * 32 * 4);
  static int grid_blocks = 0;
  if (!grid_blocks) { int dev = 0, cus = 0, per_cu = 0; hipGetDevice(&dev); hipDeviceGetAttribute(&cus, hipDeviceAttributeMultiprocessorCount, dev);
    hipOccupancyMaxActiveBlocksPerMultiprocessor(&per_cu, mega, NTHR, 0); per_cu = 1; grid_blocks = cus * per_cu; }
  p.OB0 = (float*)alloc((size_t)R * 512 * 4);
  p.bar = (unsigned*)alloc((size_t)(XCD_BAR_WORDS + 4 * NAJ + 64) * 4); p.bflag = p.bar + XCD_BAR_WORDS; p.actr = p.bflag + 4 * NAJ;
  if (wo > ws_size) { fprintf(stderr, "workspace too small: need %zu have %zu\n", wo, ws_size); return; }
  for (int l = 0; l < 4; ++l) p.lam_init[l] = (float)(0.8 - 0.6 * exp(-0.3 * (double)l));
  (void)hipMemsetAsync(p.bar, 0, (size_t)(XCD_BAR_WORDS + 4 * NAJ + 64) * 4, stream);
#if MK_MULTI
  for (int ph = 0; ph < NPH; ++ph) { hipLaunchKernelGGL(mega, dim3(grid_blocks), dim3(NTHR), 0, stream, p, ph, ph + 1); }
#else
  int lo = 0, hi = NPH; void* args[] = {&p, &lo, &hi};
  hipError_t e = hipLaunchCooperativeKernel((void*)mega, dim3(grid_blocks), dim3(NTHR), args, 0, stream);
  if (e != hipSuccess) fprintf(stderr, "cooperative launch failed: %s (grid %d)\n", hipGetErrorString(e), grid_blocks);
#endif
}
```
